# Optimizing an MI355X kernel written in HIP

```python
import math
import jax, jax.numpy as jnp
from jax import lax
import numpy as np

D_MODEL = 2048
BATCH = 4
SEQ = 2048
DEPTH = 1
DEC_BATCH = 128
DEC_SEQ = 8
PAST_LEN = 16384
PAGE_SIZE = 128

POOL_WIDTH = D_MODEL // 2
POOL_WINDOWS = (2, 4, 8, 16)
POOL_GROUPS = len(POOL_WINDOWS)
POOL_GROUP_W = POOL_WIDTH // POOL_GROUPS
POOL_BUF = max(POOL_WINDOWS) - 1
SSM_WIDTH = D_MODEL // 2
SSM_GROUP_IN = 16
SSM_GROUPS = SSM_WIDTH // SSM_GROUP_IN
SSM_STATE = 64
DT_MIN = 1e-3
DT_MAX = 1e-1
XA_HEADS = 4
XA_WIDTH = D_MODEL // 2
XA_HEAD_DIM = XA_WIDTH // XA_HEADS
N_MEM = 256
N_BRANCH = 3
IN_WIDTH = POOL_WIDTH + SSM_WIDTH + XA_WIDTH + N_BRANCH * D_MODEL
D_FF = 4 * D_MODEL
EPS = 1e-6

kernel_name = "hybrid_pool_s5_memxattn_decoder_step"

F32 = jnp.float32


def rmsnorm(x, g):
    xf = x.astype(F32)
    r = lax.rsqrt(jnp.mean(xf * xf, axis=-1, keepdims=True) + EPS)
    return (xf * r).astype(x.dtype) * g


def pool_mixer(u, prev, n_prev, pool_w, pool_scale, pool_proj):
    bsz, L, P = u.shape
    ext = jnp.concatenate([prev.astype(u.dtype), u], axis=1).astype(F32)
    cs = jnp.concatenate([jnp.zeros((bsz, 1, P), F32), jnp.cumsum(ext, axis=1)], axis=1)
    cur = ext[:, POOL_BUF:]
    end = cs[:, POOL_BUF + 1:]
    t = jnp.arange(L)
    outs = []
    for k, wdw in enumerate(POOL_WINDOWS):
        lo, hi = k * POOL_GROUP_W, (k + 1) * POOL_GROUP_W
        start = cs[:, POOL_BUF + 1 - wdw: POOL_BUF + 1 - wdw + L, lo:hi]
        cnt = jnp.minimum(t + 1 + n_prev, wdw).astype(F32)[None, :, None]
        outs.append((end[..., lo:hi] - start) / cnt - cur[..., lo:hi])
    pooled = jnp.stack(outs, axis=2)
    mixed = jnp.einsum('blgc,gcd->blgd', pooled, pool_w.astype(F32)).reshape(bsz, L, P)
    mixed = (mixed * pool_scale.astype(F32)).astype(u.dtype)
    new_buf = ext[:, -POOL_BUF:].astype(prev.dtype)
    return mixed @ pool_proj, new_buf


def _ssm_combine(e1, e2):
    a1r, a1i, b1r, b1i = e1
    a2r, a2i, b2r, b2i = e2
    ar = a2r * a1r - a2i * a1i
    ai = a2r * a1i + a2i * a1r
    br = a2r * b1r - a2i * b1i + b2r
    bi = a2r * b1i + a2i * b1r + b2i
    return (ar, ai, br, bi)


def s5_mixer(u, h_re, h_im, A_re, A_im, log_dt, B_re, B_im, C_re, C_im, D_skip, glu_w, glu_b, ssm_proj):
    bsz, L, S = u.shape
    uf = u.astype(F32)
    ug = uf.reshape(bsz, L, SSM_GROUPS, SSM_GROUP_IN)
    dt = jnp.exp(log_dt.astype(F32))[:, None]
    ar, ai = A_re.astype(F32), A_im.astype(F32)
    mag = jnp.exp(dt * ar)
    abr, abi = mag * jnp.cos(dt * ai), mag * jnp.sin(dt * ai)
    den = ar * ar + ai * ai
    xr, xi = abr - 1.0, abi
    fr = (xr * ar + xi * ai) / den
    fi = (xi * ar - xr * ai) / den
    br_, bi_ = B_re.astype(F32), B_im.astype(F32)
    bbr = fr[..., None] * br_ - fi[..., None] * bi_
    bbi = fr[..., None] * bi_ + fi[..., None] * br_
    bu_r = jnp.einsum('blgp,gnp->blgn', ug, bbr)
    bu_i = jnp.einsum('blgp,gnp->blgn', ug, bbi)
    hr0, hi0 = h_re.astype(F32), h_im.astype(F32)
    bu_r = bu_r.at[:, 0].add(abr * hr0 - abi * hi0)
    bu_i = bu_i.at[:, 0].add(abr * hi0 + abi * hr0)
    a_r = jnp.broadcast_to(abr, (1, L, SSM_GROUPS, SSM_STATE))
    a_i = jnp.broadcast_to(abi, (1, L, SSM_GROUPS, SSM_STATE))
    _, _, hr, hi = lax.associative_scan(_ssm_combine, (a_r, a_i, bu_r, bu_i), axis=1)
    y = (jnp.einsum('blgn,gpn->blgp', hr, C_re.astype(F32))
         - jnp.einsum('blgn,gpn->blgp', hi, C_im.astype(F32))).reshape(bsz, L, S)
    y = y + D_skip.astype(F32) * uf
    zg = jax.nn.gelu(y)
    zg = zg * jax.nn.sigmoid(zg @ glu_w.astype(F32) + glu_b.astype(F32))
    out = zg.astype(u.dtype) @ ssm_proj
    return out, hr[:, -1].astype(h_re.dtype), hi[:, -1].astype(h_im.dtype)


def memory_kv(mem, mem_norm_g, xa_wk, xa_wv):
    bsz, M, _ = mem.shape
    mn = rmsnorm(mem, mem_norm_g)
    k = (mn @ xa_wk).reshape(bsz, M, XA_HEADS, XA_HEAD_DIM)
    v = (mn @ xa_wv).reshape(bsz, M, XA_HEADS, XA_HEAD_DIM)
    return k, v


def memory_cross_attn(q_flat, mem_k, mem_v, xa_wo):
    bsz, L, _ = q_flat.shape
    q = q_flat.reshape(bsz, L, XA_HEADS, XA_HEAD_DIM)
    s = jnp.einsum('blhd,bmhd->bhlm', q, mem_k.astype(q.dtype)).astype(F32) * (XA_HEAD_DIM ** -0.5)
    p = jax.nn.softmax(s, axis=-1)
    o = jnp.einsum('bhlm,bmhd->blhd', p.astype(q.dtype), mem_v.astype(q.dtype)).reshape(bsz, L, XA_WIDTH)
    return o @ xa_wo


def decoder_layer(x, pool_prev, n_prev, h_re, h_im, mem_k, mem_v,
                  norm1_g, w_in, b_gate, pool_w, pool_scale, pool_proj,
                  A_re, A_im, log_dt, B_re, B_im, C_re, C_im, D_skip, glu_w, glu_b, ssm_proj,
                  xa_wo, w_out, norm2_g, mlp_w1, mlp_w2):
    bsz, L, D = x.shape
    xn = rmsnorm(x, norm1_g)
    z = xn @ w_in
    o1 = POOL_WIDTH
    o2 = o1 + SSM_WIDTH
    o3 = o2 + XA_WIDTH
    u_pool, u_ssm, q = z[..., :o1], z[..., o1:o2], z[..., o2:o3]
    gates = jax.nn.sigmoid((z[..., o3:] + b_gate.reshape(-1)).astype(F32)).reshape(bsz, L, N_BRANCH, D)
    y_pool, pool_new = pool_mixer(u_pool, pool_prev, n_prev, pool_w, pool_scale, pool_proj)
    y_ssm, hr, hi = s5_mixer(u_ssm, h_re, h_im, A_re, A_im, log_dt, B_re, B_im, C_re, C_im,
                             D_skip, glu_w, glu_b, ssm_proj)
    y_xa = memory_cross_attn(q, mem_k, mem_v, xa_wo)
    merged = (gates[:, :, 0] * y_pool.astype(F32) + gates[:, :, 1] * y_ssm.astype(F32)
              + gates[:, :, 2] * y_xa.astype(F32)).astype(x.dtype)
    x = x + merged @ w_out
    xn2 = rmsnorm(x, norm2_g)
    x = x + jnp.square(jax.nn.relu(xn2 @ mlp_w1)) @ mlp_w2
    return x, pool_new, hr, hi


def setup_inputs(seed: int = 0) -> dict:
    key = jax.random.key(seed)
    ks = iter(list(jax.random.split(key, 48)))

    def nrm(shape, scale):
        return jax.random.normal(next(ks), shape, F32) * scale

    G, N, GI = SSM_GROUPS, SSM_STATE, SSM_GROUP_IN
    n_idx = jnp.arange(N, dtype=F32)[None, None, :]
    return {
        "x_prompt": nrm((BATCH, SEQ, D_MODEL), 1.0),
        "x_sample": nrm((DEC_BATCH, DEC_SEQ, D_MODEL), 1.0),
        "state_pool": nrm((DEPTH, DEC_BATCH, POOL_BUF, POOL_WIDTH), 1.0),
        "state_ssm_re": nrm((DEPTH, DEC_BATCH, G, N), 1.0),
        "state_ssm_im": nrm((DEPTH, DEC_BATCH, G, N), 1.0),
        "cache_mem_k": nrm((DEPTH, DEC_BATCH, N_MEM, XA_HEADS, XA_HEAD_DIM), 1.0),
        "cache_mem_v": nrm((DEPTH, DEC_BATCH, N_MEM, XA_HEADS, XA_HEAD_DIM), 1.0),
        "mem_prompt": nrm((BATCH, N_MEM, D_MODEL), 1.0),
        "norm1_g": 1.0 + nrm((DEPTH, D_MODEL), 0.02),
        "w_in": nrm((DEPTH, D_MODEL, IN_WIDTH), D_MODEL ** -0.5),
        "b_gate": nrm((DEPTH, N_BRANCH, D_MODEL), 0.01),
        "pool_w": nrm((DEPTH, POOL_GROUPS, POOL_GROUP_W, POOL_GROUP_W), POOL_GROUP_W ** -0.5),
        "pool_scale": 1.0 + nrm((DEPTH, POOL_WIDTH), 0.1),
        "pool_proj": nrm((DEPTH, POOL_WIDTH, D_MODEL), POOL_WIDTH ** -0.5),
        "ssm_A_re": -0.5 + nrm((DEPTH, G, N), 0.01),
        "ssm_A_im": jnp.pi * n_idx + nrm((DEPTH, G, N), 0.01),
        "ssm_log_dt": jax.random.uniform(next(ks), (DEPTH, G), F32, math.log(DT_MIN), math.log(DT_MAX)),
        "ssm_B_re": nrm((DEPTH, G, N, GI), (2 * GI) ** -0.5),
        "ssm_B_im": nrm((DEPTH, G, N, GI), (2 * GI) ** -0.5),
        "ssm_C_re": nrm((DEPTH, G, GI, N), (2 * N) ** -0.5),
        "ssm_C_im": nrm((DEPTH, G, GI, N), (2 * N) ** -0.5),
        "ssm_D": nrm((DEPTH, SSM_WIDTH), 1.0),
        "ssm_glu_w": nrm((DEPTH, SSM_WIDTH, SSM_WIDTH), SSM_WIDTH ** -0.5),
        "ssm_glu_b": nrm((DEPTH, SSM_WIDTH), 0.01),
        "ssm_proj": nrm((DEPTH, SSM_WIDTH, D_MODEL), SSM_WIDTH ** -0.5),
        "mem_norm_g": 1.0 + nrm((DEPTH, D_MODEL), 0.02),
        "xa_wk": nrm((DEPTH, D_MODEL, XA_WIDTH), D_MODEL ** -0.5),
        "xa_wv": nrm((DEPTH, D_MODEL, XA_WIDTH), D_MODEL ** -0.5),
        "xa_wo": nrm((DEPTH, XA_WIDTH, D_MODEL), XA_WIDTH ** -0.5),
        "w_out": nrm((DEPTH, D_MODEL, D_MODEL), D_MODEL ** -0.5),
        "norm2_g": 1.0 + nrm((DEPTH, D_MODEL), 0.02),
        "mlp_w1": nrm((DEPTH, D_MODEL, D_FF), D_MODEL ** -0.5),
        "mlp_w2": nrm((DEPTH, D_FF, D_MODEL), D_FF ** -0.5),
        "final_norm_g": 1.0 + nrm((D_MODEL,), 0.02),
    }


def reference(x_prompt, x_sample, state_pool, state_ssm_re, state_ssm_im, cache_mem_k, cache_mem_v,
              mem_prompt, norm1_g, w_in, b_gate, pool_w, pool_scale, pool_proj,
              ssm_A_re, ssm_A_im, ssm_log_dt, ssm_B_re, ssm_B_im, ssm_C_re, ssm_C_im, ssm_D,
              ssm_glu_w, ssm_glu_b, ssm_proj, mem_norm_g, xa_wk, xa_wv, xa_wo, w_out,
              norm2_g, mlp_w1, mlp_w2, final_norm_g):
    n_prev_sample = min(POOL_BUF, PAST_LEN)
    xp, xs = x_prompt, x_sample
    pool_p, re_p, im_p, mk_p, mv_p = [], [], [], [], []
    pool_s, re_s, im_s = [], [], []
    for l in range(DEPTH):
        lw = (norm1_g[l], w_in[l], b_gate[l], pool_w[l], pool_scale[l], pool_proj[l],
              ssm_A_re[l], ssm_A_im[l], ssm_log_dt[l], ssm_B_re[l], ssm_B_im[l], ssm_C_re[l], ssm_C_im[l],
              ssm_D[l], ssm_glu_w[l], ssm_glu_b[l], ssm_proj[l], xa_wo[l], w_out[l],
              norm2_g[l], mlp_w1[l], mlp_w2[l])
        mk, mv = memory_kv(mem_prompt, mem_norm_g[l], xa_wk[l], xa_wv[l])
        zero_pool = jnp.zeros((xp.shape[0], POOL_BUF, POOL_WIDTH), state_pool.dtype)
        zero_h = jnp.zeros((xp.shape[0], SSM_GROUPS, SSM_STATE), state_ssm_re.dtype)
        xp, pb, hr, hi = decoder_layer(xp, zero_pool, 0, zero_h, zero_h, mk, mv, *lw)
        pool_p.append(pb); re_p.append(hr); im_p.append(hi); mk_p.append(mk); mv_p.append(mv)
        xs, pb, hr, hi = decoder_layer(xs, state_pool[l], n_prev_sample, state_ssm_re[l], state_ssm_im[l],
                                       cache_mem_k[l], cache_mem_v[l], *lw)
        pool_s.append(pb); re_s.append(hr); im_s.append(hi)
    y_prompt = rmsnorm(xp, final_norm_g)
    y_sample = rmsnorm(xs, final_norm_g)
    return (y_prompt, y_sample,
            jnp.stack(pool_p), jnp.stack(re_p), jnp.stack(im_p), jnp.stack(mk_p), jnp.stack(mv_p),
            jnp.stack(pool_s), jnp.stack(re_s), jnp.stack(im_s))
```

```cpp
#include <hip/hip_runtime.h>
#include <hip/hip_cooperative_groups.h>
#include <cstdio>
#include <cstdint>
namespace cg = cooperative_groups;

namespace pg8 {
#define PG8_LAS __attribute__((address_space(3)))
typedef unsigned short bf16_t;
typedef short bf16x8 __attribute__((ext_vector_type(8)));
typedef float f32x4 __attribute__((ext_vector_type(4)));
typedef unsigned u32x4 __attribute__((ext_vector_type(4)));
typedef unsigned u32x2 __attribute__((ext_vector_type(2)));
constexpr int BM = 256, BK = 64, HALF = 128, HTB = HALF * BK * 2, STAGE_BYTES = 8 * HTB, NXCD = 8, WGM = 8;

__host__ __device__ __forceinline__ int lds_byte(int r, int c) { const int st = (r >> 4) * 2 + (c >> 5), rr = r & 15, cc = c & 31, ob = rr * 64 + cc * 2; return st * 1024 + (ob ^ (((ob >> 9) & 1) << 5)); }
__host__ __device__ __forceinline__ void stage_rc(int b, int& R, int& C) { const int st = b / 1024, sb = b % 1024, swz = sb ^ (((sb >> 9) & 1) << 5); R = (st >> 1) * 16 + swz / 64; C = (st & 1) * 32 + (swz % 64) / 2; }
__host__ __device__ __forceinline__ int perm32(int rho) { const int n = rho >> 4, i = rho & 15; return 8 * (i >> 2) + 4 * n + (i & 3); }

struct Unit { int pm, pn, g; const char* a; const char* b; };
struct Gemm { int K, lda, ldb; };
struct Sub { const char* A; const char* B; int nM, nN, b_div, pad; long long a_pm, a_pn, b_pm, b_pn; };
template <int NS> struct MultiOrder {
    Sub s[NS]; int G, c;
    __device__ __forceinline__ bool next(int i, Unit& u) const {
        long long L = (long long)i * G + c;
#pragma unroll
        for (int k = 0; k < NS; ++k) {
            const int nM = s[k].nM, nN = s[k].nN, nwg = nM * nN;
            if (L < nwg) {
                int wgid = (int)L; { const int q = nwg / NXCD, r = nwg % NXCD, xcd = wgid % NXCD, off = wgid / NXCD; wgid = (xcd < r ? xcd * (q + 1) : r * (q + 1) + (xcd - r) * q) + off; }
                const int nig = WGM * nN, gid = wgid / nig, fm = gid * WGM, gsz = (nM - fm) < WGM ? (nM - fm) : WGM;
                u.pm = fm + ((wgid % nig) % gsz); u.pn = (wgid % nig) / gsz; u.g = k;
                u.a = s[k].A + u.pm * s[k].a_pm + u.pn * s[k].a_pn;
                u.b = s[k].B + (u.pm / s[k].b_div) * s[k].b_pm + u.pn * s[k].b_pn;
                return true;
            }
            L -= nwg;
        }
        return false;
    }
    __device__ __forceinline__ void a_ready(const Unit&) const {}
    __device__ __forceinline__ void done(const Unit&) const {}
};
__device__ __forceinline__ unsigned cvt_pk_bf16(float lo, float hi) { unsigned r; asm volatile("v_cvt_pk_bf16_f32 %0, %1, %2" : "=v"(r) : "v"(lo), "v"(hi)); return r; }

template <class Epi, class Sched, bool ALIGN_EPI = false, bool SP2 = false>
__device__ __forceinline__ void gemm_phase(PG8_LAS unsigned char* lds, const Gemm g, const Sched& S, const Epi& E) {
    int tid_ = threadIdx.x; asm volatile("" : "+v"(tid_));
    const int tid = tid_, wid = __builtin_amdgcn_readfirstlane(tid >> 6), lane = tid & 63, wr = wid >> 2, wc = wid & 3, fr = lane & 15, fq = lane >> 4;
    const int K = g.K, nt = K / BK;
    unsigned voffA[2], voffB[2];
#pragma unroll
    for (int i = 0; i < 2; ++i) { int R, C; stage_rc(tid * 16 + i * 8192, R, C); const int Rb = Epi::PERM ? ((R & ~31) + perm32(R & 31)) : R;
        voffA[i] = (unsigned)(R * g.lda + C) * 2u; voffB[i] = (unsigned)(Rb * g.ldb + C) * 2u; }
    const size_t kstep = (size_t)(BK * 2);
    const size_t hstepA = (size_t)HALF * g.lda * 2, hstepB = (size_t)HALF * g.ldb * 2;
    const unsigned ldsw = (unsigned)wid * 1024u;
    const int aoff = lds_byte(wr * 64 + fr, fq * 8), boff = lds_byte(wc * 32 + fr, fq * 8);
#define PG8_SA(b, h) (((b) * 2 + (h)) * HTB)
#define PG8_SB(b, h) ((4 + (b) * 2 + (h)) * HTB)
#define PG8_STAGE(bufoff, gbase, voff) do { _Pragma("unroll") for (int _i = 0; _i < 2; ++_i) \
        __builtin_amdgcn_global_load_lds((const unsigned*)((const char*)(gbase) + (voff)[_i]), (PG8_LAS unsigned*)(lds + (bufoff) + ldsw + _i * 8192), 16, 0, 0); } while (0)
#define PG8_LDA(dst, b, h) do { _Pragma("unroll") for (int m = 0; m < 4; ++m) _Pragma("unroll") for (int k = 0; k < 2; ++k) dst[m][k] = *(const PG8_LAS bf16x8*)(lds + PG8_SA(b, h) + aoff + m * 2048 + k * 1024); } while (0)
#define PG8_LDB(dst, b, h) do { _Pragma("unroll") for (int n = 0; n < 2; ++n) _Pragma("unroll") for (int k = 0; k < 2; ++k) dst[n][k] = *(const PG8_LAS bf16x8*)(lds + PG8_SB(b, h) + boff + n * 2048 + k * 1024); } while (0)
#define PG8_MMA(ai, bj, At, Bt) do { __builtin_amdgcn_s_setprio(1); _Pragma("unroll") for (int m = 0; m < 4; ++m) _Pragma("unroll") for (int n = 0; n < 2; ++n) _Pragma("unroll") for (int k = 0; k < 2; ++k) \
        acc[ai][bj][m][n] = __builtin_amdgcn_mfma_f32_16x16x32_bf16(Bt[n][k], At[m][k], acc[ai][bj][m][n], 0, 0, 0); __builtin_amdgcn_s_setprio(0); } while (0)
#define PG8_WAIT_V(n) asm volatile("s_waitcnt vmcnt(" #n ")" ::: "memory")
#define PG8_WAIT_L(n) asm volatile("s_waitcnt lgkmcnt(" #n ")" ::: "memory")
#define PG8_BAR __builtin_amdgcn_s_barrier()
#define PG8_SCHED __builtin_amdgcn_sched_barrier(0)
    Unit cur, nxt; int ui = 0;
    if (!S.next(0, cur)) return;
    f32x4 acc[2][2][4][2];
#pragma unroll
    for (int a = 0; a < 2; ++a)
#pragma unroll
        for (int b = 0; b < 2; ++b)
#pragma unroll
            for (int m = 0; m < 4; ++m)
#pragma unroll
                for (int n = 0; n < 2; ++n) acc[a][b][m][n] = (f32x4){0.f, 0.f, 0.f, 0.f};
    bf16x8 At[4][2], B0[2][2], B1[2][2];
    const char* cA = cur.a; const char* cB = cur.b;
    S.a_ready(cur);
    if constexpr (SP2) {
        PG8_STAGE(PG8_SB(0, 0), cB, voffB); PG8_STAGE(PG8_SB(0, 1), cB + hstepB, voffB); PG8_STAGE(PG8_SA(0, 0), cA, voffA); PG8_STAGE(PG8_SA(0, 1), cA + hstepA, voffA);
        if (wr == 1) PG8_BAR;
        PG8_WAIT_V(2); PG8_BAR;
        PG8_STAGE(PG8_SB(1, 0), cB + kstep, voffB); PG8_STAGE(PG8_SA(1, 0), cA + kstep, voffA); PG8_STAGE(PG8_SB(1, 1), cB + hstepB + kstep, voffB);
        PG8_WAIT_V(6); PG8_BAR;
    } else {
        PG8_STAGE(PG8_SB(0, 0), cB, voffB); PG8_STAGE(PG8_SA(0, 0), cA, voffA); PG8_STAGE(PG8_SB(0, 1), cB + hstepB, voffB); PG8_STAGE(PG8_SA(0, 1), cA + hstepA, voffA);
        if (wr == 1) PG8_BAR;
        PG8_WAIT_V(4); PG8_BAR;
        PG8_STAGE(PG8_SB(1, 0), cB + kstep, voffB); PG8_STAGE(PG8_SA(1, 0), cA + kstep, voffA); PG8_STAGE(PG8_SB(1, 1), cB + hstepB + kstep, voffB);
        PG8_WAIT_V(6); PG8_BAR;
    }
    for (;;) {
        const bool has_next = S.next(ui + 1, nxt);
        const char* nA = has_next ? nxt.a : cA; const char* nB = has_next ? nxt.b : cB;
        for (int t = 0; t < nt; t += 2) {
            const bool last = (t == nt - 2);
            const char* a1 = cA + (size_t)(t + 1) * kstep;
            const char* a2 = last ? nA : cA + (size_t)(t + 2) * kstep; const char* b2 = last ? nB : cB + (size_t)(t + 2) * kstep;
            const char* a3 = a2 + kstep; const char* b3 = b2 + kstep;
            if (last && has_next) S.a_ready(nxt);
            if constexpr (SP2) {
            PG8_LDB(B0, 0, 0); PG8_LDB(B1, 0, 1); PG8_SCHED; PG8_LDA(At, 0, 0); PG8_STAGE(PG8_SA(1, 1), a1 + hstepA, voffA);
            PG8_WAIT_V(8); PG8_WAIT_L(0); PG8_BAR; PG8_MMA(0, 0, At, B0); PG8_MMA(0, 1, At, B1); PG8_BAR; PG8_SCHED;
            PG8_LDA(At, 0, 1); PG8_STAGE(PG8_SB(0, 0), b2, voffB); PG8_STAGE(PG8_SB(0, 1), b2 + hstepB, voffB); PG8_STAGE(PG8_SA(0, 0), a2, voffA);
            PG8_WAIT_V(8); PG8_WAIT_L(0); PG8_BAR; PG8_MMA(1, 0, At, B0); PG8_MMA(1, 1, At, B1); PG8_BAR; PG8_SCHED;
            PG8_LDB(B0, 1, 0); PG8_LDB(B1, 1, 1); PG8_SCHED; PG8_LDA(At, 1, 0); PG8_STAGE(PG8_SA(0, 1), a2 + hstepA, voffA);
            PG8_WAIT_V(8); PG8_WAIT_L(0); PG8_BAR; PG8_MMA(0, 0, At, B0); PG8_MMA(0, 1, At, B1); PG8_BAR; PG8_SCHED;
            PG8_LDA(At, 1, 1); PG8_STAGE(PG8_SB(1, 0), b3, voffB); PG8_STAGE(PG8_SB(1, 1), b3 + hstepB, voffB); PG8_STAGE(PG8_SA(1, 0), a3, voffA);
            PG8_WAIT_V(8); PG8_WAIT_L(0); PG8_BAR; PG8_MMA(1, 0, At, B0); PG8_MMA(1, 1, At, B1); PG8_BAR; PG8_SCHED;
            } else {
            PG8_LDB(B0, 0, 0); PG8_SCHED; PG8_LDA(At, 0, 0); PG8_STAGE(PG8_SA(1, 1), a1 + hstepA, voffA);
            PG8_WAIT_L(8); PG8_BAR; PG8_WAIT_L(0); PG8_MMA(0, 0, At, B0); PG8_BAR; PG8_SCHED;
            PG8_LDB(B1, 0, 1); PG8_STAGE(PG8_SB(0, 0), b2, voffB);
            PG8_BAR; PG8_WAIT_L(0); PG8_MMA(0, 1, At, B1); PG8_BAR;
            PG8_LDA(At, 0, 1); PG8_STAGE(PG8_SA(0, 0), a2, voffA);
            PG8_BAR; PG8_WAIT_L(0); PG8_MMA(1, 0, At, B0); PG8_BAR; PG8_SCHED;
            PG8_STAGE(PG8_SB(0, 1), b2 + hstepB, voffB);
            PG8_WAIT_V(6); PG8_BAR; PG8_MMA(1, 1, At, B1); PG8_BAR;
            PG8_LDB(B0, 1, 0); PG8_SCHED; PG8_LDA(At, 1, 0); PG8_STAGE(PG8_SA(0, 1), a2 + hstepA, voffA);
            PG8_WAIT_L(8); PG8_BAR; PG8_WAIT_L(0); PG8_MMA(0, 0, At, B0); PG8_BAR; PG8_SCHED;
            PG8_LDB(B1, 1, 1); PG8_STAGE(PG8_SB(1, 0), b3, voffB);
            PG8_BAR; PG8_WAIT_L(0); PG8_MMA(0, 1, At, B1); PG8_BAR;
            PG8_LDA(At, 1, 1); PG8_STAGE(PG8_SA(1, 0), a3, voffA);
            PG8_BAR; PG8_WAIT_L(0); PG8_MMA(1, 0, At, B0); PG8_BAR; PG8_SCHED;
            PG8_STAGE(PG8_SB(1, 1), b3 + hstepB, voffB);
            PG8_WAIT_V(6); PG8_BAR; PG8_MMA(1, 1, At, B1); PG8_BAR;
            }
        }
        if constexpr (ALIGN_EPI) { if (wr == 0) PG8_BAR; }
        if constexpr (!Epi::AFTER_DRAIN) { E(acc, cur, wr, wc, fr, fq); S.done(cur); }
        if (!has_next) break;
#pragma unroll
        for (int a = 0; a < 2; ++a)
#pragma unroll
            for (int b = 0; b < 2; ++b)
#pragma unroll
                for (int m = 0; m < 4; ++m)
#pragma unroll
                    for (int n = 0; n < 2; ++n) acc[a][b][m][n] = (f32x4){0.f, 0.f, 0.f, 0.f};
        cur = nxt; cA = nA; cB = nB; ++ui;
        if constexpr (ALIGN_EPI) { if (wr == 1) PG8_BAR; }
    }
    PG8_WAIT_V(0);
    if constexpr (!ALIGN_EPI) { if (wr == 0) PG8_BAR; }
    PG8_BAR;
    if constexpr (Epi::AFTER_DRAIN) { E.fused(acc, cur, wr, wc, fr, fq, lds, wid, lane); S.done(cur); }
#undef PG8_SA
#undef PG8_SB
#undef PG8_STAGE
#undef PG8_LDA
#undef PG8_LDB
#undef PG8_MMA
#undef PG8_WAIT_V
#undef PG8_WAIT_L
#undef PG8_BAR
#undef PG8_SCHED
}
}

#define LAS __attribute__((address_space(3)))
typedef unsigned short bf16;
typedef float f32x4 __attribute__((ext_vector_type(4)));
typedef float f32x2 __attribute__((ext_vector_type(2)));
typedef unsigned u32x4 __attribute__((ext_vector_type(4)));
typedef unsigned u32x2 __attribute__((ext_vector_type(2)));
typedef short bf16x8 __attribute__((ext_vector_type(8)));
using pg8::cvt_pk_bf16;

constexpr int DM = 2048, MP = 8192, MS = 1024, MT = MP + MS;
constexpr int INW = 9216, DFF = 8192;
constexpr float EPS = 1e-6f;
constexpr size_t MiB = 1u << 20;
constexpr size_t WS_PAR = 1 * MiB;
constexpr size_t WS_WIN = 2 * MiB, WS_WKV = 40 * MiB, WS_POOLW = 48 * MiB, WS_GLUW = 49 * MiB, WS_PPROJ = 52 * MiB, WS_SPROJ = 56 * MiB, WS_XAWO = 60 * MiB;
constexpr size_t WS_WOUT = 64 * MiB, WS_W1 = 72 * MiB, WS_W2 = 104 * MiB;
constexpr size_t WS_XN = 136 * MiB, WS_MN = 172 * MiB;
constexpr size_t WS_UPOOL = 176 * MiB, WS_USSM = 212 * MiB, WS_X1 = 176 * MiB;
constexpr size_t WS_Q = 248 * MiB, WS_GATES = 266 * MiB, WS_KB = 374 * MiB, WS_VT = 376 * MiB;
constexpr size_t WS_POOLED = 378 * MiB, WS_ZG = 396 * MiB, WS_P = 414 * MiB, WS_O = 430 * MiB, WS_MIXED = 448 * MiB, WS_ZG2 = 466 * MiB;
constexpr size_t WS_MERGED = 484 * MiB, WS_X2 = 484 * MiB;
constexpr size_t WS_MERGEDB = 378 * MiB;
constexpr size_t WS_H = 248 * MiB;
constexpr size_t WS_END = 556 * MiB;
constexpr size_t PAR_AB = 0;
constexpr size_t PAR_BB = 32768;
constexpr size_t PAR_CMT = 32768 + 524288;
constexpr size_t O_YP = 0, O_YS = 16777216, O_POOLP = 18874368, O_REP = 18935808, O_IMP = 18952192, O_MK = 18968576, O_MV = 20017152, O_POOLS = 21065728, O_RES = 23031808, O_IMS = 23556096;
constexpr int LDS_BYTES = 147456;

enum { I_XP = 0, I_XS, I_SPOOL, I_SRE, I_SIM, I_CK, I_CV, I_MEM, I_N1G, I_WIN, I_BGATE, I_POOLW, I_PSCALE, I_PPROJ, I_ARE, I_AIM, I_LOGDT, I_BRE, I_BIM, I_CRE, I_CIM, I_DSK, I_GLUW, I_GLUB, I_SPROJ, I_MNG, I_WK, I_WV, I_WO, I_WOUT, I_N2G, I_W1, I_W2, I_FNG, N_IN };
struct Args { const float* in[N_IN]; float* out; unsigned char* ws; };

__device__ __forceinline__ int opq(int v) { asm volatile("" : "+v"(v)); return v; }
__device__ __forceinline__ float wave_sum(float v) {
#pragma unroll
    for (int o = 1; o < 64; o <<= 1) v += __shfl_xor(v, o);
    return v;
}
__device__ __forceinline__ float wave_max(float v) {
#pragma unroll
    for (int o = 1; o < 64; o <<= 1) v = fmaxf(v, __shfl_xor(v, o));
    return v;
}
__device__ __forceinline__ float bf2f(unsigned short b) { return __uint_as_float((unsigned)b << 16); }
__device__ __forceinline__ unsigned short f2bf(float f) { return (unsigned short)(cvt_pk_bf16(f, 0.f) & 0xffffu); }
__device__ __forceinline__ f32x4 ld_bf4(const bf16* p) { const u32x2 w = *(const u32x2*)p; return (f32x4){__uint_as_float(w.x << 16), __uint_as_float(w.x & 0xffff0000u), __uint_as_float(w.y << 16), __uint_as_float(w.y & 0xffff0000u)}; }
__device__ __forceinline__ void st_bf4(bf16* p, f32x4 v) { u32x2 w; w.x = cvt_pk_bf16(v[0], v[1]); w.y = cvt_pk_bf16(v[2], v[3]); *(u32x2*)p = w; }
__device__ __forceinline__ float sigmoidf_(float x) { return 1.0f / (1.0f + __expf(-x)); }
__device__ __forceinline__ float gelu_tanh(float y) { const float z = 0.7978845608f * (y + 0.044715f * y * y * y); const float th = 1.0f - 2.0f / (__expf(2.0f * z) + 1.0f); return 0.5f * y * (1.0f + th); }

#define EPI_LOOP(body) _Pragma("unroll") for (int ai = 0; ai < 2; ++ai) _Pragma("unroll") for (int m = 0; m < 4; ++m) _Pragma("unroll") for (int bj = 0; bj < 2; ++bj) _Pragma("unroll") for (int n = 0; n < 2; ++n) { \
        const int row = r0 + ai * 128 + m * 16, col = c0 + bj * 128 + n * 16; const f32x4 v = acc[ai][bj][m][n]; body }

struct EpiIn {
    static constexpr bool PERM = false, AFTER_DRAIN = false;
    float* upool; float* ussm; bf16* q; bf16* gates; const float* bgate; float* outk; bf16* kb; float* outv; bf16* vt;
    __device__ __forceinline__ void operator()(const f32x4 (&acc)[2][2][4][2], const pg8::Unit& u, int wr, int wc, int fr, int fq) const {
        const int r0 = u.pm * 256 + wr * 64 + fr, c0 = u.pn * 256 + wc * 32 + 4 * fq;
        if (u.g == 0) {
            if (u.pn < 8) { float* dst = (u.pn < 4) ? upool : ussm;
                EPI_LOOP( *(f32x4*)(dst + (size_t)row * 1024 + (col & 1023)) = v; )
            } else if (u.pn < 12) {
                EPI_LOOP( st_bf4(q + (size_t)row * 1024 + (col - 2048), v); )
            } else {
                EPI_LOOP( const f32x4 bg = *(const f32x4*)(bgate + (col - 3072)); f32x4 o; o[0] = sigmoidf_(v[0] + bg[0]); o[1] = sigmoidf_(v[1] + bg[1]); o[2] = sigmoidf_(v[2] + bg[2]); o[3] = sigmoidf_(v[3] + bg[3]);
                          st_bf4(gates + (size_t)row * 6144 + (col - 3072), o); )
            }
        } else if (u.g == 1) {
            EPI_LOOP( *(f32x4*)(outk + (size_t)row * 1024 + col) = v; st_bf4(kb + (size_t)row * 1024 + col, v); )
        } else {
            EPI_LOOP( outv[(size_t)(col + 0) * 1024 + row] = v[0]; outv[(size_t)(col + 1) * 1024 + row] = v[1]; outv[(size_t)(col + 2) * 1024 + row] = v[2]; outv[(size_t)(col + 3) * 1024 + row] = v[3];
                      st_bf4(vt + ((size_t)(u.pn * 256 + (row & 255))) * 1024 + u.pm * 256 + (col & 255), v); )
        }
    }
};

struct EpiSoftmax {
    static constexpr bool PERM = false, AFTER_DRAIN = true;
    bf16* P;
    __device__ __forceinline__ void fused(f32x4 (&acc)[2][2][4][2], const pg8::Unit& u, int wr, int wc, int fr, int fq, PG8_LAS unsigned char* lds, int wid, int lane) const {
        const float sc = 0.0625f * 1.4426950408889634f;
        LAS f32x2* X = (LAS f32x2*)lds;
        float mloc[2][4];
#pragma unroll
        for (int ai = 0; ai < 2; ++ai)
#pragma unroll
            for (int m = 0; m < 4; ++m) {
                float mx = -3.0e38f;
#pragma unroll
                for (int bj = 0; bj < 2; ++bj)
#pragma unroll
                    for (int n = 0; n < 2; ++n) { const f32x4 x = acc[ai][bj][m][n]; mx = fmaxf(mx, fmaxf(fmaxf(x[0], x[1]), fmaxf(x[2], x[3]))); }
                mx = fmaxf(mx, __shfl_xor(mx, 16)); mx = fmaxf(mx, __shfl_xor(mx, 32));
                float s = 0.f;
#pragma unroll
                for (int bj = 0; bj < 2; ++bj)
#pragma unroll
                    for (int n = 0; n < 2; ++n) { f32x4 x = acc[ai][bj][m][n];
#pragma unroll
                        for (int e = 0; e < 4; ++e) { x[e] = __builtin_amdgcn_exp2f((x[e] - mx) * sc); s += x[e]; }
                        acc[ai][bj][m][n] = x; }
                s += __shfl_xor(s, 16); s += __shfl_xor(s, 32);
                mloc[ai][m] = mx;
                if (fq == 0) X[(ai * 128 + wr * 64 + m * 16 + fr) * 4 + wc] = (f32x2){mx, s};
            }
        asm volatile("s_waitcnt lgkmcnt(0)" ::: "memory"); __builtin_amdgcn_s_barrier(); asm volatile("" ::: "memory");
#pragma unroll
        for (int ai = 0; ai < 2; ++ai)
#pragma unroll
            for (int m = 0; m < 4; ++m) {
                const int rt = ai * 128 + wr * 64 + m * 16 + fr;
                const f32x2 a = X[rt * 4 + 0], b = X[rt * 4 + 1], c = X[rt * 4 + 2], d = X[rt * 4 + 3];
                const float M = fmaxf(fmaxf(a.x, b.x), fmaxf(c.x, d.x));
                const float tot = a.y * __builtin_amdgcn_exp2f((a.x - M) * sc) + b.y * __builtin_amdgcn_exp2f((b.x - M) * sc) + c.y * __builtin_amdgcn_exp2f((c.x - M) * sc) + d.y * __builtin_amdgcn_exp2f((d.x - M) * sc);
                const float f = __builtin_amdgcn_exp2f((mloc[ai][m] - M) * sc) / tot;
                bf16* rowp = P + (size_t)(u.pm * 256 + rt) * 1024 + u.pn * 256 + wc * 32 + 4 * fq;
#pragma unroll
                for (int bj = 0; bj < 2; ++bj)
#pragma unroll
                    for (int n = 0; n < 2; ++n) st_bf4(rowp + bj * 128 + n * 16, acc[ai][bj][m][n] * f);
            }
        asm volatile("s_waitcnt lgkmcnt(0)" ::: "memory"); __builtin_amdgcn_s_barrier(); asm volatile("" ::: "memory");
    }
};

template <int MODE> struct EpiBf {
    static constexpr bool PERM = false, AFTER_DRAIN = false;
    bf16* out; int ld; const float* vec; const bf16* zg;
    __device__ __forceinline__ void operator()(const f32x4 (&acc)[2][2][4][2], const pg8::Unit& u, int wr, int wc, int fr, int fq) const {
        const int r0 = u.pm * 256 + wr * 64 + fr, c0 = u.pn * 256 + wc * 32 + 4 * fq;
        EPI_LOOP( f32x4 o = v;
            if (MODE == 1) { o = v * *(const f32x4*)(vec + col); }
            if (MODE == 2) { const f32x4 bb = *(const f32x4*)(vec + col); const f32x4 z = ld_bf4(zg + (size_t)row * ld + col);
                             o[0] = z[0] * sigmoidf_(v[0] + bb[0]); o[1] = z[1] * sigmoidf_(v[1] + bb[1]); o[2] = z[2] * sigmoidf_(v[2] + bb[2]); o[3] = z[3] * sigmoidf_(v[3] + bb[3]); }
            if (MODE == 3) { o[0] = fmaxf(v[0], 0.f); o[1] = fmaxf(v[1], 0.f); o[2] = fmaxf(v[2], 0.f); o[3] = fmaxf(v[3], 0.f); o = o * o; }
            st_bf4(out + (size_t)row * ld + col, o); )
    }
};

template <int BR> struct EpiMerge {
    static constexpr bool PERM = false, AFTER_DRAIN = false;
    const bf16* gates; float* merged; bf16* mergedb;
    __device__ __forceinline__ void operator()(const f32x4 (&acc)[2][2][4][2], const pg8::Unit& u, int wr, int wc, int fr, int fq) const {
        const int r0 = u.pm * 256 + wr * 64 + fr, c0 = u.pn * 256 + wc * 32 + 4 * fq;
        EPI_LOOP( const f32x4 gt = ld_bf4(gates + (size_t)row * 6144 + BR * 2048 + col); float* mp = merged + (size_t)row * 2048 + col;
            f32x4 o = gt * v; if (BR > 0) o = o + *(const f32x4*)mp;
            if (BR < 2) *(f32x4*)mp = o; else st_bf4(mergedb + (size_t)row * 2048 + col, o); )
    }
};

struct EpiResid {
    static constexpr bool PERM = false, AFTER_DRAIN = false;
    const float* base0; const float* base1; int split; float* out;
    __device__ __forceinline__ void operator()(const f32x4 (&acc)[2][2][4][2], const pg8::Unit& u, int wr, int wc, int fr, int fq) const {
        const int r0 = u.pm * 256 + wr * 64 + fr, c0 = u.pn * 256 + wc * 32 + 4 * fq;
        EPI_LOOP( const float* bp = (row < split) ? base0 + (size_t)row * 2048 + col : base1 + (size_t)(row - split) * 2048 + col;
            *(f32x4*)(out + (size_t)row * 2048 + col) = *(const f32x4*)bp + v; )
    }
};

__device__ __forceinline__ void transpose_item(const float* W, int K, int N, bf16* WT, LAS float* scr, int item, int lane, int ldk = 0) {
    if (ldk == 0) ldk = K;
    const int nblk = N / 32, kb = item / nblk, nb = item % nblk, k0 = 64 * kb, n0 = 32 * nb;
#pragma unroll 8
    for (int i = 0; i < 32; ++i) { const int kk = 2 * i + (lane >> 5); scr[kk * 33 + (lane & 31)] = W[(size_t)(k0 + kk) * N + n0 + (lane & 31)]; }
    asm volatile("s_waitcnt lgkmcnt(0)" ::: "memory");
    const int c = lane & 7;
#pragma unroll
    for (int j = 0; j < 4; ++j) { const int n = (lane >> 3) + 8 * j; const LAS float* s = scr + (8 * c) * 33 + n;
        u32x4 o; o.x = cvt_pk_bf16(s[0 * 33], s[1 * 33]); o.y = cvt_pk_bf16(s[2 * 33], s[3 * 33]); o.z = cvt_pk_bf16(s[4 * 33], s[5 * 33]); o.w = cvt_pk_bf16(s[6 * 33], s[7 * 33]);
        *(u32x4*)(WT + (size_t)(n0 + n) * ldk + k0 + 8 * c) = o; }
    asm volatile("s_waitcnt lgkmcnt(0)" ::: "memory");
}
template <bool TO_BF> __device__ __forceinline__ void rms_row(const float* xrow, const float* gw, void* orow, int lane) {
    f32x4 v[8]; float s = 0.f;
#pragma unroll
    for (int j = 0; j < 8; ++j) { v[j] = *(const f32x4*)(xrow + 4 * (lane + 64 * j)); s += (v[j][0] * v[j][0] + v[j][1] * v[j][1]) + (v[j][2] * v[j][2] + v[j][3] * v[j][3]); }
    s = wave_sum(s);
    const float r = 1.0f / sqrtf(s * (1.0f / 2048.0f) + EPS);
#pragma unroll
    for (int j = 0; j < 8; ++j) { const f32x4 g4 = *(const f32x4*)(gw + 4 * (lane + 64 * j)); const f32x4 o = (v[j] * r) * g4;
        if (TO_BF) st_bf4((bf16*)orow + 4 * (lane + 64 * j), o); else *(f32x4*)((float*)orow + 4 * (lane + 64 * j)) = o; }
}
__device__ __forceinline__ double dexp_(double x) {
    const double k = __builtin_rint(x * 1.4426950408889634); const double r = __builtin_fma(-k, 0.6931471805599453094, x);
    double p = 1.0;
#pragma unroll
    for (int i = 14; i >= 1; --i) p = 1.0 + p * r / (double)i;
    const long long e = (long long)k + 1023; const double sc = __longlong_as_double(e << 52);
    return p * sc;
}
__device__ __forceinline__ void dsincos_(double x, double& s, double& c) {
    const double k = __builtin_rint(x * 0.63661977236758134308); double r = __builtin_fma(-k, 1.57079632679489655800e+00, x); r = __builtin_fma(-k, 6.12323399573676603587e-17, r);
    const double r2 = r * r;
    double ps = 1.0, pc = 1.0;
#pragma unroll
    for (int i = 8; i >= 1; --i) { ps = 1.0 - ps * r2 / (double)((2 * i) * (2 * i + 1)); pc = 1.0 - pc * r2 / (double)((2 * i - 1) * (2 * i)); }
    ps *= r;
    const int q = ((int)((long long)k & 3ll) + 4) & 3;
    s = (q == 0) ? ps : (q == 1) ? pc : (q == 2) ? -ps : -pc;
    c = (q == 0) ? pc : (q == 1) ? -ps : (q == 2) ? -pc : ps;
}

__global__ void __launch_bounds__(512, 2) mega_fwd(Args args) {
    extern __shared__ __attribute__((aligned(16))) unsigned char lds_raw[];
    LAS unsigned char* lds = (LAS unsigned char*)lds_raw;
    cg::grid_group grid = cg::this_grid();
    const int tid0 = threadIdx.x, wave = __builtin_amdgcn_readfirstlane(tid0 >> 6);
    const int G = gridDim.x, bx = blockIdx.x;
    const int gw = bx * 8 + wave, NGW = G * 8;
    unsigned char* ws = args.ws; float* dout = args.out;
#define WIN_T ((bf16*)(ws + WS_WIN))
#define WKV_T ((bf16*)(ws + WS_WKV))
#define POOLW_T ((bf16*)(ws + WS_POOLW))
#define GLUW_T ((bf16*)(ws + WS_GLUW))
#define PPROJ_T ((bf16*)(ws + WS_PPROJ))
#define SPROJ_T ((bf16*)(ws + WS_SPROJ))
#define XAWO_T ((bf16*)(ws + WS_XAWO))
#define WOUT_T ((bf16*)(ws + WS_WOUT))
#define W1_T ((bf16*)(ws + WS_W1))
#define W2_T ((bf16*)(ws + WS_W2))
#define XN ((bf16*)(ws + WS_XN))
#define MN ((bf16*)(ws + WS_MN))
#define UPOOL ((float*)(ws + WS_UPOOL))
#define USSM ((float*)(ws + WS_USSM))
#define X1 ((float*)(ws + WS_X1))
#define QB ((bf16*)(ws + WS_Q))
#define GATES ((bf16*)(ws + WS_GATES))
#define KB ((bf16*)(ws + WS_KB))
#define VT ((bf16*)(ws + WS_VT))
#define POOLED ((bf16*)(ws + WS_POOLED))
#define ZG ((bf16*)(ws + WS_ZG))
#define PB ((bf16*)(ws + WS_P))
#define OB ((bf16*)(ws + WS_O))
#define MIXED ((bf16*)(ws + WS_MIXED))
#define ZG2 ((bf16*)(ws + WS_ZG2))
#define MERGED ((float*)(ws + WS_MERGED))
#define MERGEDB ((bf16*)(ws + WS_MERGEDB))
#define HB ((bf16*)(ws + WS_H))
#define X2 ((float*)(ws + WS_X2))
#define PAB ((float*)(ws + WS_PAR + PAR_AB))
#define PBB ((float*)(ws + WS_PAR + PAR_BB))
#define PCMT ((bf16*)(ws + WS_PAR + PAR_CMT))
    {
        const int tid = opq(tid0), lane = tid & 63; (void)tid; (void)lane;
        LAS float* scr = (LAS float*)(lds + wave * 16384);
        constexpr int I_IN = 32 * 288, I_KV = 32 * 32, I_PW = 4 * 8, I_GL = 16 * 32, I_PJ = 16 * 64, I_OUT = 32 * 64, I_1 = 32 * 256, I_2 = 128 * 64;
        constexpr int NITEMS = I_IN + 2 * I_KV + 4 * I_PW + I_GL + 3 * I_PJ + I_OUT + I_1 + I_2;
        for (int it = gw; it < NITEMS; it += NGW) {
            int r = it;
            if (r < I_IN) { transpose_item(args.in[I_WIN], 2048, 9216, WIN_T, scr, r, lane); continue; } r -= I_IN;
            if (r < I_KV) { transpose_item(args.in[I_WK], 2048, 1024, WKV_T, scr, r, lane); continue; } r -= I_KV;
            if (r < I_KV) { transpose_item(args.in[I_WV], 2048, 1024, WKV_T + (size_t)1024 * 2048, scr, r, lane); continue; } r -= I_KV;
            if (r < 4 * I_PW) { const int g = r / I_PW; transpose_item(args.in[I_POOLW] + (size_t)g * 65536, 256, 256, POOLW_T + (size_t)g * 256, scr, r % I_PW, lane, 1024); continue; } r -= 4 * I_PW;
            if (r < I_GL) { transpose_item(args.in[I_GLUW], 1024, 1024, GLUW_T, scr, r, lane); continue; } r -= I_GL;
            if (r < I_PJ) { transpose_item(args.in[I_PPROJ], 1024, 2048, PPROJ_T, scr, r, lane); continue; } r -= I_PJ;
            if (r < I_PJ) { transpose_item(args.in[I_SPROJ], 1024, 2048, SPROJ_T, scr, r, lane); continue; } r -= I_PJ;
            if (r < I_PJ) { transpose_item(args.in[I_WO], 1024, 2048, XAWO_T, scr, r, lane); continue; } r -= I_PJ;
            if (r < I_OUT) { transpose_item(args.in[I_WOUT], 2048, 2048, WOUT_T, scr, r, lane); continue; } r -= I_OUT;
            if (r < I_1) { transpose_item(args.in[I_W1], 2048, 8192, W1_T, scr, r, lane); continue; } r -= I_1;
            transpose_item(args.in[I_W2], 8192, 2048, W2_T, scr, r, lane);
        }
        for (int m = gw; m < MT; m += NGW) { const float* xr = (m < MP) ? args.in[I_XP] + (size_t)m * DM : args.in[I_XS] + (size_t)(m - MP) * DM; rms_row<true>(xr, args.in[I_N1G], XN + (size_t)m * DM, lane); }
        for (int m = gw; m < 1024; m += NGW) rms_row<true>(args.in[I_MEM] + (size_t)m * DM, args.in[I_MNG], MN + (size_t)m * DM, lane);
        for (int i = bx * 512 + tid; i < 4096; i += G * 512) {
            const int g = i >> 6, n = i & 63;
            const double dt = dexp_((double)args.in[I_LOGDT][g]); const double ar = (double)args.in[I_ARE][i], ai = (double)args.in[I_AIM][i];
            const double mag = dexp_(dt * ar); double sn, cs; dsincos_(dt * ai, sn, cs);
            const double abr = mag * cs, abi = mag * sn, den = ar * ar + ai * ai, xr = abr - 1.0, xi = abi;
            const double fr = (xr * ar + xi * ai) / den, fi = (xi * ar - xr * ai) / den;
            PAB[i * 2 + 0] = (float)abr; PAB[i * 2 + 1] = (float)abi;
            for (int p = 0; p < 16; ++p) { const double br = (double)args.in[I_BRE][i * 16 + p], bi = (double)args.in[I_BIM][i * 16 + p];
                PBB[i * 32 + p] = (float)(fr * br - fi * bi); PBB[i * 32 + 16 + p] = (float)(fr * bi + fi * br); }
            for (int p = 0; p < 16; ++p) { PCMT[(size_t)g * 2048 + p * 128 + n] = f2bf(args.in[I_CRE][(g * 16 + p) * 64 + n]); PCMT[(size_t)g * 2048 + p * 128 + 64 + n] = f2bf(-args.in[I_CIM][(g * 16 + p) * 64 + n]); }
        }
    }
    grid.sync();

    {
        pg8::MultiOrder<3> S; S.G = G; S.c = bx;
        S.s[0] = pg8::Sub{(const char*)XN, (const char*)WIN_T, 36, 36, 1, 0, 256ll * 2048 * 2, 0, 0, 256ll * 2048 * 2};
        S.s[1] = pg8::Sub{(const char*)MN, (const char*)WKV_T, 4, 4, 1, 0, 256ll * 2048 * 2, 0, 0, 256ll * 2048 * 2};
        S.s[2] = pg8::Sub{(const char*)(WKV_T + (size_t)1024 * 2048), (const char*)MN, 4, 4, 1, 0, 256ll * 2048 * 2, 0, 0, 256ll * 2048 * 2};
        EpiIn E{UPOOL, USSM, QB, GATES, args.in[I_BGATE], dout + O_MK, KB, dout + O_MV, VT};
        pg8::gemm_phase<EpiIn, pg8::MultiOrder<3>, true, true>(lds, pg8::Gemm{2048, 2048, 2048}, S, E);
    }
    grid.sync();

    {
        pg8::MultiOrder<1> S; S.G = G; S.c = bx;
        S.s[0] = pg8::Sub{(const char*)QB, (const char*)KB, 32, 4, 8, 0, 256ll * 1024 * 2, 256ll * 2, 256ll * 1024 * 2, 256ll * 2};
        EpiSoftmax E{PB};
        pg8::gemm_phase<EpiSoftmax, pg8::MultiOrder<1>, false, true>(lds, pg8::Gemm{256, 1024, 1024}, S, E);
    }
    __syncthreads();
    {
        const int tid = opq(tid0), lane = tid & 63; (void)tid; (void)lane;
        LAS float* Ub = (LAS float*)(lds + wave * 2048);
        LAS bf16* Hs = (LAS bf16*)(lds + 16384 + wave * 8704);
        LAS f32x2* Xc = (LAS f32x2*)(lds + 16384 + 8 * 8704);
        for (int job = bx; job < 256; job += G) {
            const int b = job >> 6, g = job & 63;
            const float abr = PAB[(g * 64 + lane) * 2], abi = PAB[(g * 64 + lane) * 2 + 1];
            float bbr[16], bbi[16];
#pragma unroll
            for (int p4 = 0; p4 < 4; ++p4) { const f32x4 x = *(const f32x4*)(PBB + (size_t)(g * 64 + lane) * 32 + 4 * p4), y = *(const f32x4*)(PBB + (size_t)(g * 64 + lane) * 32 + 16 + 4 * p4);
#pragma unroll
                for (int e = 0; e < 4; ++e) { bbr[4 * p4 + e] = x[e]; bbi[4 * p4 + e] = y[e]; } }
            bf16x8 cf[4];
#pragma unroll
            for (int ks = 0; ks < 4; ++ks) cf[ks] = *(const bf16x8*)(PCMT + (size_t)g * 2048 + (lane & 15) * 128 + ks * 32 + 8 * (lane >> 4));
            const float dsk = args.in[I_DSK][g * 16 + (lane & 15)];
            float pr = abr, pi = abi;
#pragma unroll
            for (int i = 0; i < 5; ++i) { const float nr = pr * pr - pi * pi, ni = 2.f * pr * pi; pr = nr; pi = ni; }
            float cr = 0.f, ci = 0.f;
            for (int blk = 0; blk < 8; ++blk) {
                const int row0 = b * 2048 + blk * 256 + wave * 32;
                { const int tok = lane >> 1, hf = lane & 1; const float* src = USSM + (size_t)(row0 + tok) * 1024 + g * 16 + hf * 8;
                  const f32x4 a0 = *(const f32x4*)src, a1 = *(const f32x4*)(src + 4); *(LAS f32x4*)(Ub + tok * 16 + hf * 8) = a0; *(LAS f32x4*)(Ub + tok * 16 + hf * 8 + 4) = a1; }
                asm volatile("s_waitcnt lgkmcnt(0)" ::: "memory");
                float hr = 0.f, hi = 0.f;
#pragma unroll 2
                for (int t = 0; t < 32; ++t) {
                    float bur = 0.f, bui = 0.f;
#pragma unroll
                    for (int p4 = 0; p4 < 4; ++p4) { const f32x4 uu = *(const LAS f32x4*)(Ub + t * 16 + 4 * p4);
#pragma unroll
                        for (int e = 0; e < 4; ++e) { bur += bbr[4 * p4 + e] * uu[e]; bui += bbi[4 * p4 + e] * uu[e]; } }
                    const float nr = abr * hr - abi * hi + bur, ni = abr * hi + abi * hr + bui; hr = nr; hi = ni;
                    Hs[t * 136 + lane] = f2bf(hr); Hs[t * 136 + 64 + lane] = f2bf(hi);
                }
                Xc[wave * 64 + lane] = (f32x2){hr, hi};
                __syncthreads();
                float hinr = 0.f, hini = 0.f, rr = cr, ri = ci;
#pragma unroll
                for (int w2 = 0; w2 < 8; ++w2) { if (w2 == wave) { hinr = rr; hini = ri; } const f32x2 e = Xc[w2 * 64 + lane]; const float nr = pr * rr - pi * ri + e.x, ni = pr * ri + pi * rr + e.y; rr = nr; ri = ni; }
                cr = rr; ci = ri;
                if (blk == 7 && wave == 7) { dout[O_REP + (size_t)(b * 64 + g) * 64 + lane] = rr; dout[O_IMP + (size_t)(b * 64 + g) * 64 + lane] = ri; }
                float qr = abr, qi = abi;
#pragma unroll 2
                for (int t = 0; t < 32; ++t) {
                    const float tr = bf2f(Hs[t * 136 + lane]) + qr * hinr - qi * hini, ti = bf2f(Hs[t * 136 + 64 + lane]) + qr * hini + qi * hinr;
                    Hs[t * 136 + lane] = f2bf(tr); Hs[t * 136 + 64 + lane] = f2bf(ti);
                    const float nq = qr * abr - qi * abi, nqi = qr * abi + qi * abr; qr = nq; qi = nqi;
                }
                asm volatile("s_waitcnt lgkmcnt(0)" ::: "memory");
#pragma unroll
                for (int rb = 0; rb < 2; ++rb) {
                    f32x4 acc = {0.f, 0.f, 0.f, 0.f};
#pragma unroll
                    for (int ks = 0; ks < 4; ++ks) { const bf16x8 af = *(const LAS bf16x8*)(Hs + (rb * 16 + (lane & 15)) * 136 + ks * 32 + 8 * (lane >> 4)); acc = __builtin_amdgcn_mfma_f32_16x16x32_bf16(af, cf[ks], acc, 0, 0, 0); }
#pragma unroll
                    for (int r = 0; r < 4; ++r) { const int t = rb * 16 + 4 * (lane >> 4) + r, p = lane & 15; const float y = acc[r] + dsk * Ub[t * 16 + p];
                        ZG[(size_t)(row0 + t) * 1024 + g * 16 + p] = f2bf(gelu_tanh(y)); }
                }
                __syncthreads();
            }
        }
        for (int job = gw; job < 8192; job += NGW) {
            const int b = job >> 6, g = job & 63;
            const float abr = PAB[(g * 64 + lane) * 2], abi = PAB[(g * 64 + lane) * 2 + 1];
            float bbr[16], bbi[16];
#pragma unroll
            for (int p4 = 0; p4 < 4; ++p4) { const f32x4 x = *(const f32x4*)(PBB + (size_t)(g * 64 + lane) * 32 + 4 * p4), y = *(const f32x4*)(PBB + (size_t)(g * 64 + lane) * 32 + 16 + 4 * p4);
#pragma unroll
                for (int e = 0; e < 4; ++e) { bbr[4 * p4 + e] = x[e]; bbi[4 * p4 + e] = y[e]; } }
            bf16x8 cf[4];
#pragma unroll
            for (int ks = 0; ks < 4; ++ks) cf[ks] = *(const bf16x8*)(PCMT + (size_t)g * 2048 + (lane & 15) * 128 + ks * 32 + 8 * (lane >> 4));
            const float dsk = args.in[I_DSK][g * 16 + (lane & 15)];
            const int row0 = MP + b * 8;
            if (lane < 16) { const int tok = lane >> 1, hf = lane & 1; const float* src = USSM + (size_t)(row0 + tok) * 1024 + g * 16 + hf * 8;
                const f32x4 a0 = *(const f32x4*)src, a1 = *(const f32x4*)(src + 4); *(LAS f32x4*)(Ub + tok * 16 + hf * 8) = a0; *(LAS f32x4*)(Ub + tok * 16 + hf * 8 + 4) = a1; }
            float hr = args.in[I_SRE][(size_t)(b * 64 + g) * 64 + lane], hi = args.in[I_SIM][(size_t)(b * 64 + g) * 64 + lane];
            asm volatile("s_waitcnt lgkmcnt(0)" ::: "memory");
#pragma unroll
            for (int t = 0; t < 8; ++t) {
                float bur = 0.f, bui = 0.f;
#pragma unroll
                for (int p4 = 0; p4 < 4; ++p4) { const f32x4 uu = *(const LAS f32x4*)(Ub + t * 16 + 4 * p4);
#pragma unroll
                    for (int e = 0; e < 4; ++e) { bur += bbr[4 * p4 + e] * uu[e]; bui += bbi[4 * p4 + e] * uu[e]; } }
                const float nr = abr * hr - abi * hi + bur, ni = abr * hi + abi * hr + bui; hr = nr; hi = ni;
                Hs[t * 136 + lane] = f2bf(hr); Hs[t * 136 + 64 + lane] = f2bf(hi);
            }
            dout[O_RES + (size_t)(b * 64 + g) * 64 + lane] = hr; dout[O_IMS + (size_t)(b * 64 + g) * 64 + lane] = hi;
            asm volatile("s_waitcnt lgkmcnt(0)" ::: "memory");
            f32x4 acc = {0.f, 0.f, 0.f, 0.f};
#pragma unroll
            for (int ks = 0; ks < 4; ++ks) { const bf16x8 af = *(const LAS bf16x8*)(Hs + (lane & 15) * 136 + ks * 32 + 8 * (lane >> 4)); acc = __builtin_amdgcn_mfma_f32_16x16x32_bf16(af, cf[ks], acc, 0, 0, 0); }
            if (lane < 32) {
#pragma unroll
                for (int r = 0; r < 4; ++r) { const int t = 4 * (lane >> 4) + r, p = lane & 15; const float y = acc[r] + dsk * Ub[t * 16 + p];
                    ZG[(size_t)(row0 + t) * 1024 + g * 16 + p] = f2bf(gelu_tanh(y)); }
            }
            asm volatile("s_waitcnt lgkmcnt(0)" ::: "memory");
        }
    }
    __syncthreads();
    {
        const int tid = opq(tid0), lane = tid & 63; (void)tid; (void)lane;
        const float* spool = args.in[I_SPOOL];
        for (int it = bx * 512 + tid; it < MT * 256; it += G * 512) {
            const int m = it >> 8, c4 = it & 255, k = c4 >> 6, w = 2 << k;
            f32x4 s = {0.f, 0.f, 0.f, 0.f}; float cnt;
            if (m < MP) { const int t = m & 2047, nv = (t + 1 < w) ? t + 1 : w; cnt = (float)nv;
                for (int j = 0; j < nv; ++j) s = s + *(const f32x4*)(UPOOL + (size_t)(m - j) * 1024 + 4 * c4);
            } else { const int bs = (m - MP) >> 3, t = (m - MP) & 7; cnt = (float)w;
                for (int j = 0; j < w; ++j) { const int e = 15 + t - j; const float* src = (e >= 15) ? UPOOL + (size_t)(MP + bs * 8 + (e - 15)) * 1024 : spool + (size_t)(bs * 15 + e) * 1024; s = s + *(const f32x4*)(src + 4 * c4); }
            }
            const f32x4 cur = *(const f32x4*)(UPOOL + (size_t)m * 1024 + 4 * c4);
            st_bf4(POOLED + (size_t)m * 1024 + 4 * c4, s / cnt - cur);
        }
        for (int it = bx * 512 + tid; it < 4 * 15 * 256; it += G * 512) { const int c4 = it & 255, i = (it >> 8) % 15, b = it / (15 * 256);
            *(f32x4*)(dout + O_POOLP + (size_t)(b * 15 + i) * 1024 + 4 * c4) = *(const f32x4*)(UPOOL + (size_t)(b * 2048 + 2033 + i) * 1024 + 4 * c4); }
        for (int it = bx * 512 + tid; it < 128 * 15 * 256; it += G * 512) { const int c4 = it & 255, i = (it >> 8) % 15, b = it / (15 * 256); const int e = 8 + i;
            const float* src = (e >= 15) ? UPOOL + (size_t)(MP + b * 8 + (e - 15)) * 1024 : spool + (size_t)(b * 15 + e) * 1024;
            *(f32x4*)(dout + O_POOLS + (size_t)(b * 15 + i) * 1024 + 4 * c4) = *(const f32x4*)(src + 4 * c4); }
    }
    {
        const int tid = opq(tid0), lane = tid & 63; (void)tid; (void)lane;
        LAS float* qs = (LAS float*)lds; LAS float* Ss = (LAS float*)(lds + 8192); LAS float* Pm = (LAS float*)(lds + 16384); LAS float* Ot = (LAS float*)(lds + 24576);
        const float* ck = args.in[I_CK]; const float* cv = args.in[I_CV];
        for (int unit = bx; unit < 512; unit += G) {
            const int b = unit >> 2, h = unit & 3;
            { const int idx = tid * 4, i = idx >> 8, d = idx & 255; const f32x4 qv = ld_bf4(QB + (size_t)(MP + b * 8 + i) * 1024 + h * 256 + d); *(LAS f32x4*)(qs + idx) = qv; }
            __syncthreads();
            f32x4 qv[8];
#pragma unroll
            for (int i = 0; i < 8; ++i) qv[i] = *(const LAS f32x4*)(qs + i * 256 + 4 * lane);
#pragma unroll 4
            for (int mm = 0; mm < 32; ++mm) {
                const int mem = wave * 32 + mm;
                const f32x4 kv = *(const f32x4*)(ck + ((size_t)(b * 256 + mem) * 4 + h) * 256 + 4 * lane);
                float p[8];
#pragma unroll
                for (int i = 0; i < 8; ++i) p[i] = (qv[i][0] * kv[0] + qv[i][1] * kv[1]) + (qv[i][2] * kv[2] + qv[i][3] * kv[3]);
                const bool h5 = (lane & 32) != 0, h4 = (lane & 16) != 0, h3 = (lane & 8) != 0;
                float r4[4], r2[2], r1;
#pragma unroll
                for (int j = 0; j < 4; ++j) { const float snd = h5 ? p[j] : p[j + 4], kp = h5 ? p[j + 4] : p[j]; r4[j] = kp + __shfl_xor(snd, 32); }
#pragma unroll
                for (int j = 0; j < 2; ++j) { const float snd = h4 ? r4[j] : r4[j + 2], kp = h4 ? r4[j + 2] : r4[j]; r2[j] = kp + __shfl_xor(snd, 16); }
                { const float snd = h3 ? r2[0] : r2[1], kp = h3 ? r2[1] : r2[0]; r1 = kp + __shfl_xor(snd, 8); }
                r1 += __shfl_xor(r1, 4); r1 += __shfl_xor(r1, 2); r1 += __shfl_xor(r1, 1);
                const int qi = (h5 ? 4 : 0) + (h4 ? 2 : 0) + (h3 ? 1 : 0);
                if ((lane & 7) == 0) Ss[qi * 256 + mem] = r1 * 0.0625f;
            }
            __syncthreads();
            { const f32x4 s4 = *(const LAS f32x4*)(Ss + wave * 256 + 4 * lane); const float mx = wave_max(fmaxf(fmaxf(s4[0], s4[1]), fmaxf(s4[2], s4[3])));
              f32x4 e; e[0] = __expf(s4[0] - mx); e[1] = __expf(s4[1] - mx); e[2] = __expf(s4[2] - mx); e[3] = __expf(s4[3] - mx);
              const float inv = 1.0f / wave_sum((e[0] + e[1]) + (e[2] + e[3]));
#pragma unroll
              for (int j = 0; j < 4; ++j) Pm[(4 * lane + j) * 8 + wave] = e[j] * inv; }
            __syncthreads();
            { const int d = tid & 255, hf = tid >> 8; float o[8];
#pragma unroll
              for (int i = 0; i < 8; ++i) o[i] = 0.f;
              const float* vp = cv + ((size_t)(b * 256 + hf * 128) * 4 + h) * 256 + d;
#pragma unroll 8
              for (int mm = 0; mm < 128; ++mm) { const float v = vp[(size_t)mm * 1024]; const f32x4 p0 = *(const LAS f32x4*)(Pm + (hf * 128 + mm) * 8), p1 = *(const LAS f32x4*)(Pm + (hf * 128 + mm) * 8 + 4);
#pragma unroll
                  for (int i = 0; i < 4; ++i) { o[i] += p0[i] * v; o[4 + i] += p1[i] * v; } }
              if (hf == 1) {
#pragma unroll
                  for (int i = 0; i < 8; ++i) Ot[i * 256 + d] = o[i]; }
              __syncthreads();
              if (hf == 0) {
#pragma unroll
                  for (int i = 0; i < 8; ++i) OB[(size_t)(MP + b * 8 + i) * 1024 + h * 256 + d] = f2bf(o[i] + Ot[i * 256 + d]); }
            }
            __syncthreads();
        }
    }
    grid.sync();

    {
        pg8::MultiOrder<1> S; S.G = G; S.c = bx;
        S.s[0] = pg8::Sub{(const char*)ZG, (const char*)GLUW_T, 36, 4, 1, 0, 256ll * 1024 * 2, 0, 0, 256ll * 1024 * 2};
        EpiBf<2> E{ZG2, 1024, args.in[I_GLUB], ZG};
        pg8::gemm_phase<EpiBf<2>, pg8::MultiOrder<1>, true, true>(lds, pg8::Gemm{1024, 1024, 1024}, S, E);
    }
    {
        pg8::MultiOrder<1> S; S.G = G; S.c = bx;
        S.s[0] = pg8::Sub{(const char*)POOLED, (const char*)POOLW_T, 36, 4, 1, 0, 256ll * 1024 * 2, 256ll * 2, 0, 256ll * 2};
        EpiBf<1> E{MIXED, 1024, args.in[I_PSCALE], nullptr};
        pg8::gemm_phase<EpiBf<1>, pg8::MultiOrder<1>, true, true>(lds, pg8::Gemm{256, 1024, 1024}, S, E);
    }
    {
        pg8::MultiOrder<1> S; S.G = G; S.c = bx;
        S.s[0] = pg8::Sub{(const char*)PB, (const char*)VT, 32, 4, 8, 0, 256ll * 1024 * 2, 256ll * 2, 256ll * 1024 * 2, 256ll * 2};
        EpiBf<0> E{OB, 1024, nullptr, nullptr};
        pg8::gemm_phase<EpiBf<0>, pg8::MultiOrder<1>, true, true>(lds, pg8::Gemm{256, 1024, 1024}, S, E);
    }
    grid.sync();

    {
        pg8::MultiOrder<1> S; S.G = G; S.c = bx;
        S.s[0] = pg8::Sub{(const char*)MIXED, (const char*)PPROJ_T, 36, 8, 1, 0, 256ll * 1024 * 2, 0, 0, 256ll * 1024 * 2};
        EpiMerge<0> E0{GATES, MERGED, MERGEDB};
        pg8::gemm_phase<EpiMerge<0>, pg8::MultiOrder<1>, true, true>(lds, pg8::Gemm{1024, 1024, 1024}, S, E0);
        S.s[0].A = (const char*)ZG2; S.s[0].B = (const char*)SPROJ_T;
        EpiMerge<1> E1{GATES, MERGED, MERGEDB};
        pg8::gemm_phase<EpiMerge<1>, pg8::MultiOrder<1>, true, true>(lds, pg8::Gemm{1024, 1024, 1024}, S, E1);
        S.s[0].A = (const char*)OB; S.s[0].B = (const char*)XAWO_T;
        EpiMerge<2> E2{GATES, MERGED, MERGEDB};
        pg8::gemm_phase<EpiMerge<2>, pg8::MultiOrder<1>, true, true>(lds, pg8::Gemm{1024, 1024, 1024}, S, E2);
    }
    grid.sync();

    {
        pg8::MultiOrder<1> S; S.G = G; S.c = bx;
        S.s[0] = pg8::Sub{(const char*)MERGEDB, (const char*)WOUT_T, 36, 8, 1, 0, 256ll * 2048 * 2, 0, 0, 256ll * 2048 * 2};
        EpiResid E{args.in[I_XP], args.in[I_XS], MP, X1};
        pg8::gemm_phase<EpiResid, pg8::MultiOrder<1>, true, true>(lds, pg8::Gemm{2048, 2048, 2048}, S, E);
    }
    grid.sync();

    { const int tid = opq(tid0), lane = tid & 63; (void)tid; (void)lane;
      for (int m = gw; m < MT; m += NGW) rms_row<true>(X1 + (size_t)m * DM, args.in[I_N2G], XN + (size_t)m * DM, lane); }
    grid.sync();

    {
        pg8::MultiOrder<1> S; S.G = G; S.c = bx;
        S.s[0] = pg8::Sub{(const char*)XN, (const char*)W1_T, 36, 32, 1, 0, 256ll * 2048 * 2, 0, 0, 256ll * 2048 * 2};
        EpiBf<3> E{HB, 8192, nullptr, nullptr};
        pg8::gemm_phase<EpiBf<3>, pg8::MultiOrder<1>, true, true>(lds, pg8::Gemm{2048, 2048, 2048}, S, E);
    }
    grid.sync();

    {
        pg8::MultiOrder<1> S; S.G = G; S.c = bx;
        S.s[0] = pg8::Sub{(const char*)HB, (const char*)W2_T, 36, 8, 1, 0, 256ll * 8192 * 2, 0, 0, 256ll * 8192 * 2};
        EpiResid E{X1, X1, MT, X2};
        pg8::gemm_phase<EpiResid, pg8::MultiOrder<1>, true, true>(lds, pg8::Gemm{8192, 8192, 8192}, S, E);
    }
    grid.sync();

    { const int tid = opq(tid0), lane = tid & 63; (void)tid; (void)lane;
      for (int m = gw; m < MT; m += NGW) rms_row<false>(X2 + (size_t)m * DM, args.in[I_FNG], dout + (size_t)m * DM, lane); }
}

extern "C" void kernel_launch(void* const* d_in, const int* in_sizes, int n_in, void* d_out, int out_size, void* d_ws, size_t ws_size, hipStream_t stream) {
    static int grid = 0;
    if (grid == 0) {
        if (n_in != N_IN || ws_size < WS_END) { fprintf(stderr, "kernel_launch: expected %d inputs and >= %zu bytes of workspace; got %d, %zu; nothing launched\n", (int)N_IN, (size_t)WS_END, n_in, ws_size); grid = -1; return; }
        int dev = 0, cus = 0, per_cu = 0;
        if (hipGetDevice(&dev) != hipSuccess || hipDeviceGetAttribute(&cus, hipDeviceAttributeMultiprocessorCount, dev) != hipSuccess) { fprintf(stderr, "kernel_launch: device query failed\n"); grid = -1; return; }
        if (hipFuncSetAttribute((const void*)mega_fwd, hipFuncAttributeMaxDynamicSharedMemorySize, LDS_BYTES) != hipSuccess) { fprintf(stderr, "kernel_launch: hipFuncSetAttribute failed\n"); grid = -1; return; }
        if (hipOccupancyMaxActiveBlocksPerMultiprocessor(&per_cu, (const void*)mega_fwd, 512, LDS_BYTES) != hipSuccess || per_cu < 1) { fprintf(stderr, "kernel_launch: occupancy query says %d blocks per CU\n", per_cu); per_cu = 1; }
        (void)hipGetLastError();
        grid = cus;
        if (grid > 256) grid = 256;
        if (grid < 144) fprintf(stderr, "kernel_launch: only %d CUs; the one-unit-per-workgroup attention phase needs >= 144\n", grid);
    }
    if (grid < 0) return;
    Args a{};
    for (int i = 0; i < N_IN; ++i) a.in[i] = (const float*)d_in[i];
    a.out = (float*)d_out; a.ws = (unsigned char*)d_ws;
    void* kargs[] = {&a};
    hipError_t e = hipLaunchCooperativeKernel((const void*)mega_fwd, dim3(grid), dim3(512), kargs, LDS_BYTES, stream);
    if (e != hipSuccess) fprintf(stderr, "kernel_launch: cooperative launch failed: %s (grid %d)\n", hipGetErrorString(e), grid);
}
```

```cpp
#include <hip/hip_runtime.h>
#include <hip/hip_cooperative_groups.h>
#include <cstdio>
#include <cstdint>
namespace cg = cooperative_groups;

namespace pg8 {
#define PG8_LAS __attribute__((address_space(3)))
typedef unsigned short bf16_t;
typedef short bf16x8 __attribute__((ext_vector_type(8)));
typedef float f32x4 __attribute__((ext_vector_type(4)));
typedef unsigned u32x4 __attribute__((ext_vector_type(4)));
typedef unsigned u32x2 __attribute__((ext_vector_type(2)));
constexpr int BM = 256, BK = 64, HALF = 128, HTB = HALF * BK * 2, STAGE_BYTES = 8 * HTB, NXCD = 8, WGM = 8;

__host__ __device__ __forceinline__ int lds_byte(int r, int c) { const int st = (r >> 4) * 2 + (c >> 5), rr = r & 15, cc = c & 31, ob = rr * 64 + cc * 2; return st * 1024 + (ob ^ (((ob >> 9) & 1) << 5)); }
__host__ __device__ __forceinline__ void stage_rc(int b, int& R, int& C) { const int st = b / 1024, sb = b % 1024, swz = sb ^ (((sb >> 9) & 1) << 5); R = (st >> 1) * 16 + swz / 64; C = (st & 1) * 32 + (swz % 64) / 2; }
__host__ __device__ __forceinline__ int perm32(int rho) { const int n = rho >> 4, i = rho & 15; return 8 * (i >> 2) + 4 * n + (i & 3); }

struct Unit { int pm, pn, g, nt, kind, peer, np; const char* a; const char* b; };
struct Gemm { int K, lda, ldb; };
struct Sub { const char* A; const char* B; int nM, nN, b_div, pad; long long a_pm, a_pn, b_pm, b_pn; };
template <int NS> struct MultiOrder {
    static constexpr bool STREAMK = false;
    Sub s[NS]; int G, c, nt;
    __device__ __forceinline__ bool next(int i, Unit& u) const {
        long long L = (long long)i * G + c;
#pragma unroll
        for (int k = 0; k < NS; ++k) {
            const int nM = s[k].nM, nN = s[k].nN, nwg = nM * nN;
            if (L < nwg) {
                int wgid = (int)L; { const int q = nwg / NXCD, r = nwg % NXCD, xcd = wgid % NXCD, off = wgid / NXCD; wgid = (xcd < r ? xcd * (q + 1) : r * (q + 1) + (xcd - r) * q) + off; }
                const int nig = WGM * nN, gid = wgid / nig, fm = gid * WGM, gsz = (nM - fm) < WGM ? (nM - fm) : WGM;
                u.pm = fm + ((wgid % nig) % gsz); u.pn = (wgid % nig) / gsz; u.g = k; u.nt = nt; u.kind = 0; u.peer = 0; u.np = 0;
                u.a = s[k].A + u.pm * s[k].a_pm + u.pn * s[k].a_pn;
                u.b = s[k].B + (u.pm / s[k].b_div) * s[k].b_pm + u.pn * s[k].b_pn;
                return true;
            }
            L -= nwg;
        }
        return false;
    }
    __device__ __forceinline__ void a_ready(const Unit&) const {}
    __device__ __forceinline__ void done(const Unit&) const {}
};

template <int NS, int NP> struct StreamK {
    static constexpr bool STREAMK = true; static constexpr int NPART = NP;
    Sub s[NS]; int nt, G, c, R, ch, U; bool split = true; unsigned seq, ackseq; unsigned* flags; unsigned* acks; unsigned char* slab;
#ifndef SK_NOSPLIT
#define SK_NOSPLIT 0
#endif
    __device__ __forceinline__ void init(int G_, int bx, int total_units) { G = G_; c = bx; U = total_units; R = U / G; ch = ((U - R * G) * nt) / G; if (SK_NOSPLIT || !split) { R = (U + G - 1) / G; ch = 0; } }
    __device__ __forceinline__ void map(int L0, Unit& u, int kt0) const {
        int L = L0;
#pragma unroll
        for (int k = 0; k < NS; ++k) {
            const int nM = s[k].nM, nN = s[k].nN, nwg = nM * nN;
            if (L < nwg || k == NS - 1) {
                int wgid = L; { const int q = nwg / NXCD, r = nwg % NXCD, xcd = wgid % NXCD, off = wgid / NXCD; wgid = (xcd < r ? xcd * (q + 1) : r * (q + 1) + (xcd - r) * q) + off; }
                const int nig = WGM * nN, gid = wgid / nig, fm = gid * WGM, gsz = (nM - fm) < WGM ? (nM - fm) : WGM;
                u.pm = fm + ((wgid % nig) % gsz); u.pn = (wgid % nig) / gsz; u.g = k;
                u.a = s[k].A + u.pm * s[k].a_pm + u.pn * s[k].a_pn + (long long)kt0 * (BK * 2);
                u.b = s[k].B + (u.pm / s[k].b_div) * s[k].b_pm + u.pn * s[k].b_pn + (long long)kt0 * (BK * 2);
                return;
            }
            L -= nwg;
        }
    }
    __device__ __forceinline__ bool next(int i, Unit& u) const {
        if (i < R) { if (i * G + c >= U) return false; u.nt = nt; u.kind = 0; u.peer = 0; u.np = 0; map(i * G + c, u, 0); return true; }
        if (ch == 0) return false;
        const int j = i - R, lb = ch * c, le = lb + ch, un = lb / nt + j, us = un * nt; const int st = (j == 0) ? lb : us; const int en = (le < us + nt) ? le : us + nt;
        if (st >= en) return false;
        const int len = en - st;
        u.nt = len; u.peer = c; u.np = 0;
        if (len == nt) u.kind = 0; else if (st != us) u.kind = 1; else { u.kind = 2; u.np = (nt - len + ch - 1) / ch; }
        map(R * G + un, u, st - us);
        return true;
    }
    __device__ __forceinline__ void a_ready(const Unit&) const {}
    __device__ __forceinline__ void done(const Unit&) const {}
};
__device__ __forceinline__ unsigned cvt_pk_bf16(float lo, float hi) { unsigned r; asm volatile("v_cvt_pk_bf16_f32 %0, %1, %2" : "=v"(r) : "v"(lo), "v"(hi)); return r; }

template <class Epi, class Sched, bool ALIGN_EPI = false, bool SP2 = false>
__device__ __forceinline__ void gemm_phase(PG8_LAS unsigned char* lds, const Gemm g, const Sched& S, const Epi& E) {
    int tid_ = threadIdx.x; asm volatile("" : "+v"(tid_));
    const int tid = tid_, wid = __builtin_amdgcn_readfirstlane(tid >> 6), lane = tid & 63, wr = wid >> 2, wc = wid & 3, fr = lane & 15, fq = lane >> 4;
    (void)g.K;
    unsigned voffA[2], voffB[2];
#pragma unroll
    for (int i = 0; i < 2; ++i) { int R, C; stage_rc(tid * 16 + i * 8192, R, C); const int Rb = Epi::PERM ? ((R & ~31) + perm32(R & 31)) : R;
        voffA[i] = (unsigned)(R * g.lda + C) * 2u; voffB[i] = (unsigned)(Rb * g.ldb + C) * 2u; }
    const size_t kstep = (size_t)(BK * 2);
    const size_t hstepA = (size_t)HALF * g.lda * 2, hstepB = (size_t)HALF * g.ldb * 2;
    const unsigned ldsw = (unsigned)wid * 1024u;
    const int aoff = lds_byte(wr * 64 + fr, fq * 8), boff = lds_byte(wc * 32 + fr, fq * 8);
#define PG8_SA(b, h) (((b) * 2 + (h)) * HTB)
#define PG8_SB(b, h) ((4 + (b) * 2 + (h)) * HTB)
#define PG8_STAGE(bufoff, gbase, voff) do { _Pragma("unroll") for (int _i = 0; _i < 2; ++_i) \
        __builtin_amdgcn_global_load_lds((const unsigned*)((const char*)(gbase) + (voff)[_i]), (PG8_LAS unsigned*)(lds + (bufoff) + ldsw + _i * 8192), 16, 0, 0); } while (0)
#define PG8_LDA(dst, b, h) do { _Pragma("unroll") for (int m = 0; m < 4; ++m) _Pragma("unroll") for (int k = 0; k < 2; ++k) dst[m][k] = *(const PG8_LAS bf16x8*)(lds + PG8_SA(b, h) + aoff + m * 2048 + k * 1024); } while (0)
#define PG8_LDB(dst, b, h) do { _Pragma("unroll") for (int n = 0; n < 2; ++n) _Pragma("unroll") for (int k = 0; k < 2; ++k) dst[n][k] = *(const PG8_LAS bf16x8*)(lds + PG8_SB(b, h) + boff + n * 2048 + k * 1024); } while (0)
#define PG8_MMA(ai, bj, At, Bt) do { __builtin_amdgcn_s_setprio(1); _Pragma("unroll") for (int m = 0; m < 4; ++m) _Pragma("unroll") for (int n = 0; n < 2; ++n) _Pragma("unroll") for (int k = 0; k < 2; ++k) \
        acc[ai][bj][m][n] = __builtin_amdgcn_mfma_f32_16x16x32_bf16(Bt[n][k], At[m][k], acc[ai][bj][m][n], 0, 0, 0); __builtin_amdgcn_s_setprio(0); } while (0)
#define PG8_WAIT_V(n) asm volatile("s_waitcnt vmcnt(" #n ")" ::: "memory")
#define PG8_WAIT_L(n) asm volatile("s_waitcnt lgkmcnt(" #n ")" ::: "memory")
#define PG8_BAR __builtin_amdgcn_s_barrier()
#define PG8_SCHED __builtin_amdgcn_sched_barrier(0)
    Unit cur, nxt; int ui = 0;
    if (!S.next(0, cur)) return;
    f32x4 acc[2][2][4][2];
#pragma unroll
    for (int a = 0; a < 2; ++a)
#pragma unroll
        for (int b = 0; b < 2; ++b)
#pragma unroll
            for (int m = 0; m < 4; ++m)
#pragma unroll
                for (int n = 0; n < 2; ++n) acc[a][b][m][n] = (f32x4){0.f, 0.f, 0.f, 0.f};
    bf16x8 At[4][2], B0[2][2], B1[2][2];
    const char* cA = cur.a; const char* cB = cur.b;
    S.a_ready(cur);
    if constexpr (SP2) {
        PG8_STAGE(PG8_SB(0, 0), cB, voffB); PG8_STAGE(PG8_SB(0, 1), cB + hstepB, voffB); PG8_STAGE(PG8_SA(0, 0), cA, voffA); PG8_STAGE(PG8_SA(0, 1), cA + hstepA, voffA);
        if (wr == 1) PG8_BAR;
        PG8_WAIT_V(2); PG8_BAR;
        PG8_STAGE(PG8_SB(1, 0), cB + kstep, voffB); PG8_STAGE(PG8_SA(1, 0), cA + kstep, voffA); PG8_STAGE(PG8_SB(1, 1), cB + hstepB + kstep, voffB);
        PG8_WAIT_V(6); PG8_BAR;
    } else {
        PG8_STAGE(PG8_SB(0, 0), cB, voffB); PG8_STAGE(PG8_SA(0, 0), cA, voffA); PG8_STAGE(PG8_SB(0, 1), cB + hstepB, voffB); PG8_STAGE(PG8_SA(0, 1), cA + hstepA, voffA);
        if (wr == 1) PG8_BAR;
        PG8_WAIT_V(4); PG8_BAR;
        PG8_STAGE(PG8_SB(1, 0), cB + kstep, voffB); PG8_STAGE(PG8_SA(1, 0), cA + kstep, voffA); PG8_STAGE(PG8_SB(1, 1), cB + hstepB + kstep, voffB);
        PG8_WAIT_V(6); PG8_BAR;
    }
    for (;;) {
        const bool has_next = S.next(ui + 1, nxt);
        const char* nA = has_next ? nxt.a : cA; const char* nB = has_next ? nxt.b : cB;
        const int nt = cur.nt;
        for (int t = 0; t < nt; t += 2) {
            if constexpr (Epi::HOOK) { if (t == 16 || t == 32) E.hook(acc, cur, wr, wc, fr, fq, t >> 4); }
            const bool last = (t == nt - 2);
            const char* a1 = cA + (size_t)(t + 1) * kstep;
            const char* a2 = last ? nA : cA + (size_t)(t + 2) * kstep; const char* b2 = last ? nB : cB + (size_t)(t + 2) * kstep;
            const char* a3 = a2 + kstep; const char* b3 = b2 + kstep;
            if (last && has_next) S.a_ready(nxt);
            if constexpr (SP2) {
            PG8_LDB(B0, 0, 0); PG8_LDB(B1, 0, 1); PG8_SCHED; PG8_LDA(At, 0, 0); PG8_STAGE(PG8_SA(1, 1), a1 + hstepA, voffA);
            PG8_WAIT_V(8); PG8_WAIT_L(0); PG8_BAR; PG8_MMA(0, 0, At, B0); PG8_MMA(0, 1, At, B1); PG8_BAR; PG8_SCHED;
            PG8_LDA(At, 0, 1); PG8_STAGE(PG8_SB(0, 0), b2, voffB); PG8_STAGE(PG8_SB(0, 1), b2 + hstepB, voffB); PG8_STAGE(PG8_SA(0, 0), a2, voffA);
            PG8_WAIT_V(8); PG8_WAIT_L(0); PG8_BAR; PG8_MMA(1, 0, At, B0); PG8_MMA(1, 1, At, B1); PG8_BAR; PG8_SCHED;
            PG8_LDB(B0, 1, 0); PG8_LDB(B1, 1, 1); PG8_SCHED; PG8_LDA(At, 1, 0); PG8_STAGE(PG8_SA(0, 1), a2 + hstepA, voffA);
            PG8_WAIT_V(8); PG8_WAIT_L(0); PG8_BAR; PG8_MMA(0, 0, At, B0); PG8_MMA(0, 1, At, B1); PG8_BAR; PG8_SCHED;
            PG8_LDA(At, 1, 1); PG8_STAGE(PG8_SB(1, 0), b3, voffB); PG8_STAGE(PG8_SB(1, 1), b3 + hstepB, voffB); PG8_STAGE(PG8_SA(1, 0), a3, voffA);
            PG8_WAIT_V(8); PG8_WAIT_L(0); PG8_BAR; PG8_MMA(1, 0, At, B0); PG8_MMA(1, 1, At, B1); PG8_BAR; PG8_SCHED;
            } else {
            PG8_LDB(B0, 0, 0); PG8_SCHED; PG8_LDA(At, 0, 0); PG8_STAGE(PG8_SA(1, 1), a1 + hstepA, voffA);
            PG8_WAIT_L(8); PG8_BAR; PG8_WAIT_L(0); PG8_MMA(0, 0, At, B0); PG8_BAR; PG8_SCHED;
            PG8_LDB(B1, 0, 1); PG8_STAGE(PG8_SB(0, 0), b2, voffB);
            PG8_BAR; PG8_WAIT_L(0); PG8_MMA(0, 1, At, B1); PG8_BAR;
            PG8_LDA(At, 0, 1); PG8_STAGE(PG8_SA(0, 0), a2, voffA);
            PG8_BAR; PG8_WAIT_L(0); PG8_MMA(1, 0, At, B0); PG8_BAR; PG8_SCHED;
            PG8_STAGE(PG8_SB(0, 1), b2 + hstepB, voffB);
            PG8_WAIT_V(6); PG8_BAR; PG8_MMA(1, 1, At, B1); PG8_BAR;
            PG8_LDB(B0, 1, 0); PG8_SCHED; PG8_LDA(At, 1, 0); PG8_STAGE(PG8_SA(0, 1), a2 + hstepA, voffA);
            PG8_WAIT_L(8); PG8_BAR; PG8_WAIT_L(0); PG8_MMA(0, 0, At, B0); PG8_BAR; PG8_SCHED;
            PG8_LDB(B1, 1, 1); PG8_STAGE(PG8_SB(1, 0), b3, voffB);
            PG8_BAR; PG8_WAIT_L(0); PG8_MMA(0, 1, At, B1); PG8_BAR;
            PG8_LDA(At, 1, 1); PG8_STAGE(PG8_SA(1, 0), a3, voffA);
            PG8_BAR; PG8_WAIT_L(0); PG8_MMA(1, 0, At, B0); PG8_BAR; PG8_SCHED;
            PG8_STAGE(PG8_SB(1, 1), b3 + hstepB, voffB);
            PG8_WAIT_V(6); PG8_BAR; PG8_MMA(1, 1, At, B1); PG8_BAR;
            }
        }
        if constexpr (ALIGN_EPI) { if (wr == 0) PG8_BAR; }
        if constexpr (!Epi::AFTER_DRAIN) {
            if constexpr (Sched::STREAMK) {
                static_assert(ALIGN_EPI, "stream-K pieces need both half-workgroups aligned at the epilogue");
                int tid_e = tid; asm volatile("" : "+v"(tid_e));
                if (cur.kind == 1) {
                    if (S.ackseq) { if (tid == 0) { unsigned sp = 0; while (__hip_atomic_load(S.acks + cur.peer, __ATOMIC_RELAXED, __HIP_MEMORY_SCOPE_AGENT) < S.ackseq && ++sp < (1u << 22)) __builtin_amdgcn_s_sleep(2); } PG8_BAR; }
                    f32x4* sl = (f32x4*)(S.slab + (size_t)cur.peer * 262144) + tid_e;
#pragma unroll
                    for (int a = 0; a < 2; ++a)
#pragma unroll
                        for (int b = 0; b < 2; ++b)
#pragma unroll
                            for (int m = 0; m < 4; ++m)
#pragma unroll
                                for (int n = 0; n < 2; ++n) { f32x4* sp_ = sl + (((a * 2 + b) * 4 + m) * 2 + n) * 512; asm volatile("global_store_dwordx4 %0, %1, off sc1\n\ts_nop 1" :: "v"(sp_), "v"(acc[a][b][m][n]) : "memory"); }
                    asm volatile("s_waitcnt vmcnt(0)" ::: "memory");
                    PG8_BAR;
                    if (tid == 0) __hip_atomic_store(S.flags + cur.peer, S.seq, __ATOMIC_RELAXED, __HIP_MEMORY_SCOPE_AGENT);
                } else if (cur.kind == 2) {
                    if (tid == 0) { for (int p = 1; p <= cur.np; ++p) { unsigned sp = 0; while (__hip_atomic_load(S.flags + cur.peer + p, __ATOMIC_RELAXED, __HIP_MEMORY_SCOPE_AGENT) < S.seq && ++sp < (1u << 22)) __builtin_amdgcn_s_sleep(2); }
                        __builtin_amdgcn_fence(__ATOMIC_ACQUIRE, "agent"); asm volatile("s_waitcnt vmcnt(0)" ::: "memory"); }
                    PG8_BAR; asm volatile("" ::: "memory");
                    E.template run<Sched::NPART>(acc, cur, wr, wc, fr, fq, (const f32x4*)(S.slab + (size_t)(cur.peer + 1) * 262144) + tid_e);
                    asm volatile("s_waitcnt vmcnt(0)" ::: "memory");
                    PG8_BAR;
                    if (tid == 0) { for (int p = 1; p <= cur.np; ++p) __hip_atomic_store(S.acks + cur.peer + p, S.seq, __ATOMIC_RELAXED, __HIP_MEMORY_SCOPE_AGENT); }
                } else { E.template run<0>(acc, cur, wr, wc, fr, fq, (const f32x4*)nullptr); }
            } else { E.template run<0>(acc, cur, wr, wc, fr, fq, (const f32x4*)nullptr); }
            S.done(cur); }
        if (!has_next) break;
#pragma unroll
        for (int a = 0; a < 2; ++a)
#pragma unroll
            for (int b = 0; b < 2; ++b)
#pragma unroll
                for (int m = 0; m < 4; ++m)
#pragma unroll
                    for (int n = 0; n < 2; ++n) acc[a][b][m][n] = (f32x4){0.f, 0.f, 0.f, 0.f};
        cur = nxt; cA = nA; cB = nB; ++ui;
        if constexpr (ALIGN_EPI) { if (wr == 1) PG8_BAR; }
    }
    PG8_WAIT_V(0);
    if constexpr (!ALIGN_EPI) { if (wr == 0) PG8_BAR; }
    PG8_BAR;
    if constexpr (Epi::AFTER_DRAIN) { E.fused(acc, cur, wr, wc, fr, fq, lds, wid, lane); S.done(cur); }
#undef PG8_SA
#undef PG8_SB
#undef PG8_STAGE
#undef PG8_LDA
#undef PG8_LDB
#undef PG8_MMA
#undef PG8_WAIT_V
#undef PG8_WAIT_L
#undef PG8_BAR
#undef PG8_SCHED
}
}

#define LAS __attribute__((address_space(3)))
typedef unsigned short bf16;
typedef float f32x4 __attribute__((ext_vector_type(4)));
typedef float f32x2 __attribute__((ext_vector_type(2)));
typedef unsigned u32x4 __attribute__((ext_vector_type(4)));
typedef unsigned u32x2 __attribute__((ext_vector_type(2)));
typedef short bf16x8 __attribute__((ext_vector_type(8)));
using pg8::cvt_pk_bf16;

constexpr int DM = 2048, MP = 8192, MS = 1024, MT = MP + MS;
constexpr int INW = 9216, DFF = 8192;
constexpr float EPS = 1e-6f;
constexpr size_t MiB = 1u << 20;
constexpr size_t WS_PAR = 1 * MiB;
constexpr size_t WS_WIN = 2 * MiB, WS_WKV = 40 * MiB, WS_POOLW = 48 * MiB, WS_GLUW = 49 * MiB, WS_PPROJ = 52 * MiB, WS_SPROJ = 56 * MiB, WS_XAWO = 60 * MiB;
constexpr size_t WS_WOUT = 64 * MiB, WS_W1 = 72 * MiB, WS_W2 = 104 * MiB;
constexpr size_t WS_XN = 136 * MiB, WS_MN = 172 * MiB;
constexpr size_t WS_UPOOL = 176 * MiB, WS_USSM = 212 * MiB, WS_X1 = 176 * MiB;
constexpr size_t WS_Q = 248 * MiB, WS_GATES = 266 * MiB, WS_KB = 374 * MiB, WS_VT = 376 * MiB;
constexpr size_t WS_POOLED = 378 * MiB, WS_ZG = 396 * MiB, WS_P = 414 * MiB, WS_ACAT = 448 * MiB;
constexpr size_t WS_MERGED = 484 * MiB, WS_X2 = 392 * MiB;
constexpr size_t WS_SLAB = 484 * MiB, WS_SLAB4 = 176 * MiB;
constexpr size_t WS_FLAGS = 0, WS_ACKS = 1024;
constexpr size_t WS_MERGEDB = 378 * MiB;
constexpr size_t WS_H = 248 * MiB;
constexpr size_t WS_END = 556 * MiB;
constexpr size_t PAR_AB = 0;
constexpr size_t PAR_BB = 32768;
constexpr size_t PAR_CMT = 32768 + 524288;
constexpr size_t O_YP = 0, O_YS = 16777216, O_POOLP = 18874368, O_REP = 18935808, O_IMP = 18952192, O_MK = 18968576, O_MV = 20017152, O_POOLS = 21065728, O_RES = 23031808, O_IMS = 23556096;
constexpr int LDS_BYTES = 147456;
#ifndef SPLIT_P1
#define SPLIT_P1 false
#endif
#ifndef SPLIT_P2
#define SPLIT_P2 false
#endif
#ifndef SPLIT_P5
#define SPLIT_P5 false
#endif
#ifndef SPLIT_P6
#define SPLIT_P6 false
#endif
#ifndef SPLIT_P7
#define SPLIT_P7 true
#endif

enum { I_XP = 0, I_XS, I_SPOOL, I_SRE, I_SIM, I_CK, I_CV, I_MEM, I_N1G, I_WIN, I_BGATE, I_POOLW, I_PSCALE, I_PPROJ, I_ARE, I_AIM, I_LOGDT, I_BRE, I_BIM, I_CRE, I_CIM, I_DSK, I_GLUW, I_GLUB, I_SPROJ, I_MNG, I_WK, I_WV, I_WO, I_WOUT, I_N2G, I_W1, I_W2, I_FNG, N_IN };
struct Args { const float* in[N_IN]; float* out; unsigned char* ws; };

__device__ __forceinline__ int opq(int v) { asm volatile("" : "+v"(v)); return v; }
__device__ __forceinline__ float wave_sum(float v) {
#pragma unroll
    for (int o = 1; o < 64; o <<= 1) v += __shfl_xor(v, o);
    return v;
}
__device__ __forceinline__ float wave_max(float v) {
#pragma unroll
    for (int o = 1; o < 64; o <<= 1) v = fmaxf(v, __shfl_xor(v, o));
    return v;
}
__device__ __forceinline__ float bf2f(unsigned short b) { return __uint_as_float((unsigned)b << 16); }
__device__ __forceinline__ unsigned short f2bf(float f) { return (unsigned short)(cvt_pk_bf16(f, 0.f) & 0xffffu); }
__device__ __forceinline__ f32x4 ld_bf4(const bf16* p) { const u32x2 w = *(const u32x2*)p; return (f32x4){__uint_as_float(w.x << 16), __uint_as_float(w.x & 0xffff0000u), __uint_as_float(w.y << 16), __uint_as_float(w.y & 0xffff0000u)}; }
__device__ __forceinline__ void st_bf4(bf16* p, f32x4 v) { u32x2 w; w.x = cvt_pk_bf16(v[0], v[1]); w.y = cvt_pk_bf16(v[2], v[3]); *(u32x2*)p = w; }
__device__ __forceinline__ float sigmoidf_(float x) { return 1.0f / (1.0f + __expf(-x)); }
__device__ __forceinline__ float gelu_tanh(float y) { const float z = 0.7978845608f * (y + 0.044715f * y * y * y); const float th = 1.0f - 2.0f / (__expf(2.0f * z) + 1.0f); return 0.5f * y * (1.0f + th); }

#define EPI_LOOP(body) _Pragma("unroll") for (int ai = 0; ai < 2; ++ai) _Pragma("unroll") for (int m = 0; m < 4; ++m) _Pragma("unroll") for (int bj = 0; bj < 2; ++bj) _Pragma("unroll") for (int n = 0; n < 2; ++n) { \
        const int row = r0 + ai * 128 + m * 16, col = c0 + bj * 128 + n * 16; f32x4 v = acc[ai][bj][m][n]; _Pragma("unroll") for (int p_ = 0; p_ < PART; ++p_) v = v + part[(size_t)p_ * 16384 + ((((ai * 2 + bj) * 4 + m) * 2 + n)) * 512]; body }

struct EpiIn {
    static constexpr bool PERM = false, AFTER_DRAIN = false, HOOK = false;
    float* upool; float* ussm; bf16* q; bf16* gates; const float* bgate; float* outk; bf16* kb; float* outv; bf16* vt;
    template <int PART> __device__ __forceinline__ void run(const f32x4 (&acc)[2][2][4][2], const pg8::Unit& u, int wr, int wc, int fr, int fq, const f32x4* part) const {
        const int r0 = u.pm * 256 + wr * 64 + fr, c0 = u.pn * 256 + wc * 32 + 4 * fq;
        if (u.g == 0) {
            if (u.pn < 8) { float* dst = (u.pn < 4) ? upool : ussm;
                EPI_LOOP( *(f32x4*)(dst + (size_t)row * 1024 + (col & 1023)) = v; )
            } else if (u.pn < 12) {
                EPI_LOOP( st_bf4(q + (size_t)row * 1024 + (col - 2048), v); )
            } else {
                EPI_LOOP( const f32x4 bg = *(const f32x4*)(bgate + (col - 3072)); f32x4 o; o[0] = sigmoidf_(v[0] + bg[0]); o[1] = sigmoidf_(v[1] + bg[1]); o[2] = sigmoidf_(v[2] + bg[2]); o[3] = sigmoidf_(v[3] + bg[3]);
                          st_bf4(gates + (size_t)row * 6144 + (col - 3072), o); )
            }
        } else if (u.g == 1) {
            EPI_LOOP( *(f32x4*)(outk + (size_t)row * 1024 + col) = v; st_bf4(kb + (size_t)row * 1024 + col, v); )
        } else {
            EPI_LOOP( outv[(size_t)(col + 0) * 1024 + row] = v[0]; outv[(size_t)(col + 1) * 1024 + row] = v[1]; outv[(size_t)(col + 2) * 1024 + row] = v[2]; outv[(size_t)(col + 3) * 1024 + row] = v[3];
                      st_bf4(vt + ((size_t)(u.pn * 256 + (row & 255))) * 1024 + u.pm * 256 + (col & 255), v); )
        }
    }
};

struct EpiSoftmax {
    static constexpr bool PERM = false, AFTER_DRAIN = true, HOOK = false;
    bf16* P;
    __device__ __forceinline__ void fused(f32x4 (&acc)[2][2][4][2], const pg8::Unit& u, int wr, int wc, int fr, int fq, PG8_LAS unsigned char* lds, int wid, int lane) const {
        const float sc = 0.0625f * 1.4426950408889634f;
        LAS f32x2* X = (LAS f32x2*)lds;
        float mloc[2][4];
#pragma unroll
        for (int ai = 0; ai < 2; ++ai)
#pragma unroll
            for (int m = 0; m < 4; ++m) {
                float mx = -3.0e38f;
#pragma unroll
                for (int bj = 0; bj < 2; ++bj)
#pragma unroll
                    for (int n = 0; n < 2; ++n) { const f32x4 x = acc[ai][bj][m][n]; mx = fmaxf(mx, fmaxf(fmaxf(x[0], x[1]), fmaxf(x[2], x[3]))); }
                mx = fmaxf(mx, __shfl_xor(mx, 16)); mx = fmaxf(mx, __shfl_xor(mx, 32));
                float s = 0.f;
#pragma unroll
                for (int bj = 0; bj < 2; ++bj)
#pragma unroll
                    for (int n = 0; n < 2; ++n) { f32x4 x = acc[ai][bj][m][n];
#pragma unroll
                        for (int e = 0; e < 4; ++e) { x[e] = __builtin_amdgcn_exp2f((x[e] - mx) * sc); s += x[e]; }
                        acc[ai][bj][m][n] = x; }
                s += __shfl_xor(s, 16); s += __shfl_xor(s, 32);
                mloc[ai][m] = mx;
                if (fq == 0) X[(ai * 128 + wr * 64 + m * 16 + fr) * 4 + wc] = (f32x2){mx, s};
            }
        asm volatile("s_waitcnt lgkmcnt(0)" ::: "memory"); __builtin_amdgcn_s_barrier(); asm volatile("" ::: "memory");
#pragma unroll
        for (int ai = 0; ai < 2; ++ai)
#pragma unroll
            for (int m = 0; m < 4; ++m) {
                const int rt = ai * 128 + wr * 64 + m * 16 + fr;
                const f32x2 a = X[rt * 4 + 0], b = X[rt * 4 + 1], c = X[rt * 4 + 2], d = X[rt * 4 + 3];
                const float M = fmaxf(fmaxf(a.x, b.x), fmaxf(c.x, d.x));
                const float tot = a.y * __builtin_amdgcn_exp2f((a.x - M) * sc) + b.y * __builtin_amdgcn_exp2f((b.x - M) * sc) + c.y * __builtin_amdgcn_exp2f((c.x - M) * sc) + d.y * __builtin_amdgcn_exp2f((d.x - M) * sc);
                const float f = __builtin_amdgcn_exp2f((mloc[ai][m] - M) * sc) / tot;
                bf16* rowp = P + (size_t)(u.pm * 256 + rt) * 1024 + u.pn * 256 + wc * 32 + 4 * fq;
#pragma unroll
                for (int bj = 0; bj < 2; ++bj)
#pragma unroll
                    for (int n = 0; n < 2; ++n) st_bf4(rowp + bj * 128 + n * 16, acc[ai][bj][m][n] * f);
            }
        asm volatile("s_waitcnt lgkmcnt(0)" ::: "memory"); __builtin_amdgcn_s_barrier(); asm volatile("" ::: "memory");
    }
};

template <int MODE> struct EpiBf {
    static constexpr bool PERM = false, AFTER_DRAIN = false, HOOK = false;
    bf16* out; int ld; const float* vec; const bf16* zg; int zld;
    template <int PART> __device__ __forceinline__ void run(const f32x4 (&acc)[2][2][4][2], const pg8::Unit& u, int wr, int wc, int fr, int fq, const f32x4* part) const {
        const int r0 = u.pm * 256 + wr * 64 + fr, c0 = u.pn * 256 + wc * 32 + 4 * fq;
        EPI_LOOP( f32x4 o = v;
            if (MODE == 1) { o = v * *(const f32x4*)(vec + col); }
            if (MODE == 2) { const f32x4 bb = *(const f32x4*)(vec + col); const f32x4 z = ld_bf4(zg + (size_t)row * zld + col);
                             o[0] = z[0] * sigmoidf_(v[0] + bb[0]); o[1] = z[1] * sigmoidf_(v[1] + bb[1]); o[2] = z[2] * sigmoidf_(v[2] + bb[2]); o[3] = z[3] * sigmoidf_(v[3] + bb[3]); }
            if (MODE == 3) { o[0] = fmaxf(v[0], 0.f); o[1] = fmaxf(v[1], 0.f); o[2] = fmaxf(v[2], 0.f); o[3] = fmaxf(v[3], 0.f); o = o * o; }
            st_bf4(out + (size_t)row * ld + col, o); )
    }
};

struct EpiMergeK {
    static constexpr bool PERM = false, AFTER_DRAIN = false, HOOK = true;
    const bf16* gates; bf16* mergedb;
    __device__ __forceinline__ void hook(f32x4 (&acc)[2][2][4][2], const pg8::Unit& u, int wr, int wc, int fr, int fq, int br) const {
        asm volatile("" : "+v"(fr), "+v"(fq));
        const int r0 = u.pm * 256 + wr * 64 + fr, c0 = u.pn * 256 + wc * 32 + 4 * fq;
#pragma unroll
        for (int ai = 0; ai < 2; ++ai)
#pragma unroll
            for (int m = 0; m < 4; ++m)
#pragma unroll
                for (int bj = 0; bj < 2; ++bj)
#pragma unroll
                    for (int n = 0; n < 2; ++n) { const int row = r0 + ai * 128 + m * 16, col = c0 + bj * 128 + n * 16; const bf16* gp = gates + (size_t)row * 6144 + (br - 1) * 2048 + col;
                        const f32x4 a = ld_bf4(gp), b = ld_bf4(gp + 2048); f32x4 v = acc[ai][bj][m][n];
#pragma unroll
                        for (int e = 0; e < 4; ++e) v[e] = v[e] * (a[e] * __builtin_amdgcn_rcpf(fmaxf(b[e], 1e-30f)));
                        acc[ai][bj][m][n] = v; if (bj == 1 && n == 1) asm volatile("" ::: "memory"); }
    }
    template <int PART> __device__ __forceinline__ void run(const f32x4 (&acc)[2][2][4][2], const pg8::Unit& u, int wr, int wc, int fr, int fq, const f32x4* part) const {
        const int r0 = u.pm * 256 + wr * 64 + fr, c0 = u.pn * 256 + wc * 32 + 4 * fq;
        EPI_LOOP( const f32x4 gt = ld_bf4(gates + (size_t)row * 6144 + 2 * 2048 + col); st_bf4(mergedb + (size_t)row * 2048 + col, gt * v); )
    }
};

struct EpiResid {
    static constexpr bool PERM = false, AFTER_DRAIN = false, HOOK = false;
    const float* base0; const float* base1; int split; float* out;
    template <int PART> __device__ __forceinline__ void run(const f32x4 (&acc)[2][2][4][2], const pg8::Unit& u, int wr, int wc, int fr, int fq, const f32x4* part) const {
        const int r0 = u.pm * 256 + wr * 64 + fr, c0 = u.pn * 256 + wc * 32 + 4 * fq;
        EPI_LOOP( const float* bp = (row < split) ? base0 + (size_t)row * 2048 + col : base1 + (size_t)(row - split) * 2048 + col;
            *(f32x4*)(out + (size_t)row * 2048 + col) = *(const f32x4*)bp + v; )
    }
};

__device__ __forceinline__ void transpose_item(const float* W, int K, int N, bf16* WT, LAS float* scr, int item, int lane, int ldk = 0) {
    if (ldk == 0) ldk = K;
    const int nblk = N / 32, kb = item / nblk, nb = item % nblk, k0 = 64 * kb, n0 = 32 * nb;
#pragma unroll 8
    for (int i = 0; i < 32; ++i) { const int kk = 2 * i + (lane >> 5); scr[kk * 33 + (lane & 31)] = W[(size_t)(k0 + kk) * N + n0 + (lane & 31)]; }
    asm volatile("s_waitcnt lgkmcnt(0)" ::: "memory");
    const int c = lane & 7;
#pragma unroll
    for (int j = 0; j < 4; ++j) { const int n = (lane >> 3) + 8 * j; const LAS float* s = scr + (8 * c) * 33 + n;
        u32x4 o; o.x = cvt_pk_bf16(s[0 * 33], s[1 * 33]); o.y = cvt_pk_bf16(s[2 * 33], s[3 * 33]); o.z = cvt_pk_bf16(s[4 * 33], s[5 * 33]); o.w = cvt_pk_bf16(s[6 * 33], s[7 * 33]);
        *(u32x4*)(WT + (size_t)(n0 + n) * ldk + k0 + 8 * c) = o; }
    asm volatile("s_waitcnt lgkmcnt(0)" ::: "memory");
}
template <bool TO_BF> __device__ __forceinline__ void rms_row(const float* xrow, const float* gw, void* orow, int lane) {
    f32x4 v[8]; float s = 0.f;
#pragma unroll
    for (int j = 0; j < 8; ++j) { v[j] = *(const f32x4*)(xrow + 4 * (lane + 64 * j)); s += (v[j][0] * v[j][0] + v[j][1] * v[j][1]) + (v[j][2] * v[j][2] + v[j][3] * v[j][3]); }
    s = wave_sum(s);
    const float r = 1.0f / sqrtf(s * (1.0f / 2048.0f) + EPS);
#pragma unroll
    for (int j = 0; j < 8; ++j) { const f32x4 g4 = *(const f32x4*)(gw + 4 * (lane + 64 * j)); const f32x4 o = (v[j] * r) * g4;
        if (TO_BF) st_bf4((bf16*)orow + 4 * (lane + 64 * j), o); else *(f32x4*)((float*)orow + 4 * (lane + 64 * j)) = o; }
}
__device__ __forceinline__ double dexp_(double x) {
    const double k = __builtin_rint(x * 1.4426950408889634); const double r = __builtin_fma(-k, 0.6931471805599453094, x);
    double p = 1.0;
#pragma unroll
    for (int i = 14; i >= 1; --i) p = 1.0 + p * r / (double)i;
    const long long e = (long long)k + 1023; const double sc = __longlong_as_double(e << 52);
    return p * sc;
}
__device__ __forceinline__ void dsincos_(double x, double& s, double& c) {
    const double k = __builtin_rint(x * 0.63661977236758134308); double r = __builtin_fma(-k, 1.57079632679489655800e+00, x); r = __builtin_fma(-k, 6.12323399573676603587e-17, r);
    const double r2 = r * r;
    double ps = 1.0, pc = 1.0;
#pragma unroll
    for (int i = 8; i >= 1; --i) { ps = 1.0 - ps * r2 / (double)((2 * i) * (2 * i + 1)); pc = 1.0 - pc * r2 / (double)((2 * i - 1) * (2 * i)); }
    ps *= r;
    const int q = ((int)((long long)k & 3ll) + 4) & 3;
    s = (q == 0) ? ps : (q == 1) ? pc : (q == 2) ? -ps : -pc;
    c = (q == 0) ? pc : (q == 1) ? -ps : (q == 2) ? -pc : ps;
}

__global__ void __launch_bounds__(512, 2) mega_fwd(Args args) {
    extern __shared__ __attribute__((aligned(16))) unsigned char lds_raw[];
    LAS unsigned char* lds = (LAS unsigned char*)lds_raw;
    cg::grid_group grid = cg::this_grid();
    const int tid0 = threadIdx.x, wave = __builtin_amdgcn_readfirstlane(tid0 >> 6);
    const int G = gridDim.x, bx = blockIdx.x;
    const int gw = bx * 8 + wave, NGW = G * 8;
    unsigned char* ws = args.ws; float* dout = args.out;
#define WIN_T ((bf16*)(ws + WS_WIN))
#define WKV_T ((bf16*)(ws + WS_WKV))
#define POOLW_T ((bf16*)(ws + WS_POOLW))
#define GLUW_T ((bf16*)(ws + WS_GLUW))
#define BCAT ((bf16*)(ws + WS_PPROJ))
#define WOUT_T ((bf16*)(ws + WS_WOUT))
#define W1_T ((bf16*)(ws + WS_W1))
#define W2_T ((bf16*)(ws + WS_W2))
#define XN ((bf16*)(ws + WS_XN))
#define MN ((bf16*)(ws + WS_MN))
#define UPOOL ((float*)(ws + WS_UPOOL))
#define USSM ((float*)(ws + WS_USSM))
#define X1 ((float*)(ws + WS_X1))
#define QB ((bf16*)(ws + WS_Q))
#define GATES ((bf16*)(ws + WS_GATES))
#define KB ((bf16*)(ws + WS_KB))
#define VT ((bf16*)(ws + WS_VT))
#define POOLED ((bf16*)(ws + WS_POOLED))
#define ZG ((bf16*)(ws + WS_ZG))
#define PB ((bf16*)(ws + WS_P))
#define ACAT ((bf16*)(ws + WS_ACAT))
#define MERGEDB ((bf16*)(ws + WS_MERGEDB))
#define HB ((bf16*)(ws + WS_H))
#define X2 ((float*)(ws + WS_X2))
#define PAB ((float*)(ws + WS_PAR + PAR_AB))
#define PBB ((float*)(ws + WS_PAR + PAR_BB))
#define PCMT ((bf16*)(ws + WS_PAR + PAR_CMT))
    {
        const int tid = opq(tid0), lane = tid & 63; (void)tid; (void)lane;
        LAS float* scr = (LAS float*)(lds + wave * 16384);
        constexpr int I_IN = 32 * 288, I_KV = 32 * 32, I_PW = 4 * 8, I_GL = 16 * 32, I_PJ = 16 * 64, I_OUT = 32 * 64, I_1 = 32 * 256, I_2 = 128 * 64;
        constexpr int NITEMS = I_IN + 2 * I_KV + 4 * I_PW + I_GL + 3 * I_PJ + I_OUT + I_1 + I_2;
        for (int it = gw; it < NITEMS; it += NGW) {
            int r = it;
            if (r < I_IN) { transpose_item(args.in[I_WIN], 2048, 9216, WIN_T, scr, r, lane); continue; } r -= I_IN;
            if (r < I_KV) { transpose_item(args.in[I_WK], 2048, 1024, WKV_T, scr, r, lane); continue; } r -= I_KV;
            if (r < I_KV) { transpose_item(args.in[I_WV], 2048, 1024, WKV_T + (size_t)1024 * 2048, scr, r, lane); continue; } r -= I_KV;
            if (r < 4 * I_PW) { const int g = r / I_PW; transpose_item(args.in[I_POOLW] + (size_t)g * 65536, 256, 256, POOLW_T + (size_t)g * 256, scr, r % I_PW, lane, 1024); continue; } r -= 4 * I_PW;
            if (r < I_GL) { transpose_item(args.in[I_GLUW], 1024, 1024, GLUW_T, scr, r, lane); continue; } r -= I_GL;
            if (r < I_PJ) { transpose_item(args.in[I_PPROJ], 1024, 2048, BCAT, scr, r, lane, 3072); continue; } r -= I_PJ;
            if (r < I_PJ) { transpose_item(args.in[I_SPROJ], 1024, 2048, BCAT + 1024, scr, r, lane, 3072); continue; } r -= I_PJ;
            if (r < I_PJ) { transpose_item(args.in[I_WO], 1024, 2048, BCAT + 2048, scr, r, lane, 3072); continue; } r -= I_PJ;
            if (r < I_OUT) { transpose_item(args.in[I_WOUT], 2048, 2048, WOUT_T, scr, r, lane); continue; } r -= I_OUT;
            if (r < I_1) { transpose_item(args.in[I_W1], 2048, 8192, W1_T, scr, r, lane); continue; } r -= I_1;
            transpose_item(args.in[I_W2], 8192, 2048, W2_T, scr, r, lane);
        }
        for (int m = gw; m < MT; m += NGW) { const float* xr = (m < MP) ? args.in[I_XP] + (size_t)m * DM : args.in[I_XS] + (size_t)(m - MP) * DM; rms_row<true>(xr, args.in[I_N1G], XN + (size_t)m * DM, lane); }
        for (int m = gw; m < 1024; m += NGW) rms_row<true>(args.in[I_MEM] + (size_t)m * DM, args.in[I_MNG], MN + (size_t)m * DM, lane);
        for (int i = bx * 512 + tid; i < 4096; i += G * 512) {
            const int g = i >> 6, n = i & 63;
            const double dt = dexp_((double)args.in[I_LOGDT][g]); const double ar = (double)args.in[I_ARE][i], ai = (double)args.in[I_AIM][i];
            const double mag = dexp_(dt * ar); double sn, cs; dsincos_(dt * ai, sn, cs);
            const double abr = mag * cs, abi = mag * sn, den = ar * ar + ai * ai, xr = abr - 1.0, xi = abi;
            const double fr = (xr * ar + xi * ai) / den, fi = (xi * ar - xr * ai) / den;
            PAB[i * 2 + 0] = (float)abr; PAB[i * 2 + 1] = (float)abi;
            for (int p = 0; p < 16; ++p) { const double br = (double)args.in[I_BRE][i * 16 + p], bi = (double)args.in[I_BIM][i * 16 + p];
                PBB[i * 32 + p] = (float)(fr * br - fi * bi); PBB[i * 32 + 16 + p] = (float)(fr * bi + fi * br); }
            for (int p = 0; p < 16; ++p) { PCMT[(size_t)g * 2048 + p * 128 + n] = f2bf(args.in[I_CRE][(g * 16 + p) * 64 + n]); PCMT[(size_t)g * 2048 + p * 128 + 64 + n] = f2bf(-args.in[I_CIM][(g * 16 + p) * 64 + n]); }
        }
    }
    grid.sync();

    {
        pg8::StreamK<3, 5> S; S.nt = 32; S.seq = 1; S.ackseq = 0; S.split = SPLIT_P1; S.flags = (unsigned*)(ws + WS_FLAGS); S.acks = (unsigned*)(ws + WS_ACKS); S.slab = ws + WS_SLAB; S.init(G, bx, 1296 + 32);
        S.s[0] = pg8::Sub{(const char*)XN, (const char*)WIN_T, 36, 36, 1, 0, 256ll * 2048 * 2, 0, 0, 256ll * 2048 * 2};
        S.s[1] = pg8::Sub{(const char*)MN, (const char*)WKV_T, 4, 4, 1, 0, 256ll * 2048 * 2, 0, 0, 256ll * 2048 * 2};
        S.s[2] = pg8::Sub{(const char*)(WKV_T + (size_t)1024 * 2048), (const char*)MN, 4, 4, 1, 0, 256ll * 2048 * 2, 0, 0, 256ll * 2048 * 2};
        EpiIn E{UPOOL, USSM, QB, GATES, args.in[I_BGATE], dout + O_MK, KB, dout + O_MV, VT};
        pg8::gemm_phase<EpiIn, pg8::StreamK<3, 5>, true, true>(lds, pg8::Gemm{2048, 2048, 2048}, S, E);
    }
    grid.sync();

    {
        pg8::MultiOrder<1> S; S.G = G; S.c = bx; S.nt = 4;
        S.s[0] = pg8::Sub{(const char*)QB, (const char*)KB, 32, 4, 8, 0, 256ll * 1024 * 2, 256ll * 2, 256ll * 1024 * 2, 256ll * 2};
        EpiSoftmax E{PB};
        pg8::gemm_phase<EpiSoftmax, pg8::MultiOrder<1>, false, true>(lds, pg8::Gemm{256, 1024, 1024}, S, E);
    }
    __syncthreads();
    {
        const int tid = opq(tid0), lane = tid & 63; (void)tid; (void)lane;
        LAS float* Ub = (LAS float*)(lds + wave * 2048);
        LAS bf16* Hs = (LAS bf16*)(lds + 16384 + wave * 8704);
        LAS f32x2* Xc = (LAS f32x2*)(lds + 16384 + 8 * 8704);
        for (int job = bx; job < 256; job += G) {
            const int b = job >> 6, g = job & 63;
            const float abr = PAB[(g * 64 + lane) * 2], abi = PAB[(g * 64 + lane) * 2 + 1];
            float bbr[16], bbi[16];
#pragma unroll
            for (int p4 = 0; p4 < 4; ++p4) { const f32x4 x = *(const f32x4*)(PBB + (size_t)(g * 64 + lane) * 32 + 4 * p4), y = *(const f32x4*)(PBB + (size_t)(g * 64 + lane) * 32 + 16 + 4 * p4);
#pragma unroll
                for (int e = 0; e < 4; ++e) { bbr[4 * p4 + e] = x[e]; bbi[4 * p4 + e] = y[e]; } }
            bf16x8 cf[4];
#pragma unroll
            for (int ks = 0; ks < 4; ++ks) cf[ks] = *(const bf16x8*)(PCMT + (size_t)g * 2048 + (lane & 15) * 128 + ks * 32 + 8 * (lane >> 4));
            const float dsk = args.in[I_DSK][g * 16 + (lane & 15)];
            float pr = abr, pi = abi;
#pragma unroll
            for (int i = 0; i < 5; ++i) { const float nr = pr * pr - pi * pi, ni = 2.f * pr * pi; pr = nr; pi = ni; }
            float cr = 0.f, ci = 0.f;
            for (int blk = 0; blk < 8; ++blk) {
                const int row0 = b * 2048 + blk * 256 + wave * 32;
                { const int tok = lane >> 1, hf = lane & 1; const float* src = USSM + (size_t)(row0 + tok) * 1024 + g * 16 + hf * 8;
                  const f32x4 a0 = *(const f32x4*)src, a1 = *(const f32x4*)(src + 4); *(LAS f32x4*)(Ub + tok * 16 + hf * 8) = a0; *(LAS f32x4*)(Ub + tok * 16 + hf * 8 + 4) = a1; }
                asm volatile("s_waitcnt lgkmcnt(0)" ::: "memory");
                float hr = 0.f, hi = 0.f;
#pragma unroll 2
                for (int t = 0; t < 32; ++t) {
                    float bur = 0.f, bui = 0.f;
#pragma unroll
                    for (int p4 = 0; p4 < 4; ++p4) { const f32x4 uu = *(const LAS f32x4*)(Ub + t * 16 + 4 * p4);
#pragma unroll
                        for (int e = 0; e < 4; ++e) { bur += bbr[4 * p4 + e] * uu[e]; bui += bbi[4 * p4 + e] * uu[e]; } }
                    const float nr = abr * hr - abi * hi + bur, ni = abr * hi + abi * hr + bui; hr = nr; hi = ni;
                    Hs[t * 136 + lane] = f2bf(hr); Hs[t * 136 + 64 + lane] = f2bf(hi);
                }
                Xc[wave * 64 + lane] = (f32x2){hr, hi};
                __syncthreads();
                float hinr = 0.f, hini = 0.f, rr = cr, ri = ci;
#pragma unroll
                for (int w2 = 0; w2 < 8; ++w2) { if (w2 == wave) { hinr = rr; hini = ri; } const f32x2 e = Xc[w2 * 64 + lane]; const float nr = pr * rr - pi * ri + e.x, ni = pr * ri + pi * rr + e.y; rr = nr; ri = ni; }
                cr = rr; ci = ri;
                if (blk == 7 && wave == 7) { dout[O_REP + (size_t)(b * 64 + g) * 64 + lane] = rr; dout[O_IMP + (size_t)(b * 64 + g) * 64 + lane] = ri; }
                float qr = abr, qi = abi;
#pragma unroll 2
                for (int t = 0; t < 32; ++t) {
                    const float tr = bf2f(Hs[t * 136 + lane]) + qr * hinr - qi * hini, ti = bf2f(Hs[t * 136 + 64 + lane]) + qr * hini + qi * hinr;
                    Hs[t * 136 + lane] = f2bf(tr); Hs[t * 136 + 64 + lane] = f2bf(ti);
                    const float nq = qr * abr - qi * abi, nqi = qr * abi + qi * abr; qr = nq; qi = nqi;
                }
                asm volatile("s_waitcnt lgkmcnt(0)" ::: "memory");
#pragma unroll
                for (int rb = 0; rb < 2; ++rb) {
                    f32x4 acc = {0.f, 0.f, 0.f, 0.f};
#pragma unroll
                    for (int ks = 0; ks < 4; ++ks) { const bf16x8 af = *(const LAS bf16x8*)(Hs + (rb * 16 + (lane & 15)) * 136 + ks * 32 + 8 * (lane >> 4)); acc = __builtin_amdgcn_mfma_f32_16x16x32_bf16(af, cf[ks], acc, 0, 0, 0); }
#pragma unroll
                    for (int r = 0; r < 4; ++r) { const int t = rb * 16 + 4 * (lane >> 4) + r, p = lane & 15; const float y = acc[r] + dsk * Ub[t * 16 + p];
                        ZG[(size_t)(row0 + t) * 1024 + g * 16 + p] = f2bf(gelu_tanh(y)); }
                }
                __syncthreads();
            }
        }
        for (int job = gw; job < 8192; job += NGW) {
            const int b = job >> 6, g = job & 63;
            const float abr = PAB[(g * 64 + lane) * 2], abi = PAB[(g * 64 + lane) * 2 + 1];
            float bbr[16], bbi[16];
#pragma unroll
            for (int p4 = 0; p4 < 4; ++p4) { const f32x4 x = *(const f32x4*)(PBB + (size_t)(g * 64 + lane) * 32 + 4 * p4), y = *(const f32x4*)(PBB + (size_t)(g * 64 + lane) * 32 + 16 + 4 * p4);
#pragma unroll
                for (int e = 0; e < 4; ++e) { bbr[4 * p4 + e] = x[e]; bbi[4 * p4 + e] = y[e]; } }
            bf16x8 cf[4];
#pragma unroll
            for (int ks = 0; ks < 4; ++ks) cf[ks] = *(const bf16x8*)(PCMT + (size_t)g * 2048 + (lane & 15) * 128 + ks * 32 + 8 * (lane >> 4));
            const float dsk = args.in[I_DSK][g * 16 + (lane & 15)];
            const int row0 = MP + b * 8;
            if (lane < 16) { const int tok = lane >> 1, hf = lane & 1; const float* src = USSM + (size_t)(row0 + tok) * 1024 + g * 16 + hf * 8;
                const f32x4 a0 = *(const f32x4*)src, a1 = *(const f32x4*)(src + 4); *(LAS f32x4*)(Ub + tok * 16 + hf * 8) = a0; *(LAS f32x4*)(Ub + tok * 16 + hf * 8 + 4) = a1; }
            float hr = args.in[I_SRE][(size_t)(b * 64 + g) * 64 + lane], hi = args.in[I_SIM][(size_t)(b * 64 + g) * 64 + lane];
            asm volatile("s_waitcnt lgkmcnt(0)" ::: "memory");
#pragma unroll
            for (int t = 0; t < 8; ++t) {
                float bur = 0.f, bui = 0.f;
#pragma unroll
                for (int p4 = 0; p4 < 4; ++p4) { const f32x4 uu = *(const LAS f32x4*)(Ub + t * 16 + 4 * p4);
#pragma unroll
                    for (int e = 0; e < 4; ++e) { bur += bbr[4 * p4 + e] * uu[e]; bui += bbi[4 * p4 + e] * uu[e]; } }
                const float nr = abr * hr - abi * hi + bur, ni = abr * hi + abi * hr + bui; hr = nr; hi = ni;
                Hs[t * 136 + lane] = f2bf(hr); Hs[t * 136 + 64 + lane] = f2bf(hi);
            }
            dout[O_RES + (size_t)(b * 64 + g) * 64 + lane] = hr; dout[O_IMS + (size_t)(b * 64 + g) * 64 + lane] = hi;
            asm volatile("s_waitcnt lgkmcnt(0)" ::: "memory");
            f32x4 acc = {0.f, 0.f, 0.f, 0.f};
#pragma unroll
            for (int ks = 0; ks < 4; ++ks) { const bf16x8 af = *(const LAS bf16x8*)(Hs + (lane & 15) * 136 + ks * 32 + 8 * (lane >> 4)); acc = __builtin_amdgcn_mfma_f32_16x16x32_bf16(af, cf[ks], acc, 0, 0, 0); }
            if (lane < 32) {
#pragma unroll
                for (int r = 0; r < 4; ++r) { const int t = 4 * (lane >> 4) + r, p = lane & 15; const float y = acc[r] + dsk * Ub[t * 16 + p];
                    ZG[(size_t)(row0 + t) * 1024 + g * 16 + p] = f2bf(gelu_tanh(y)); }
            }
            asm volatile("s_waitcnt lgkmcnt(0)" ::: "memory");
        }
    }
    __syncthreads();
    {
        const int tid = opq(tid0), lane = tid & 63; (void)tid; (void)lane;
        const float* spool = args.in[I_SPOOL];
        for (int it = bx * 512 + tid; it < MT * 256; it += G * 512) {
            const int m = it >> 8, c4 = it & 255, k = c4 >> 6, w = 2 << k;
            f32x4 s = {0.f, 0.f, 0.f, 0.f}; float cnt;
            if (m < MP) { const int t = m & 2047, nv = (t + 1 < w) ? t + 1 : w; cnt = (float)nv;
                for (int j = 0; j < nv; ++j) s = s + *(const f32x4*)(UPOOL + (size_t)(m - j) * 1024 + 4 * c4);
            } else { const int bs = (m - MP) >> 3, t = (m - MP) & 7; cnt = (float)w;
                for (int j = 0; j < w; ++j) { const int e = 15 + t - j; const float* src = (e >= 15) ? UPOOL + (size_t)(MP + bs * 8 + (e - 15)) * 1024 : spool + (size_t)(bs * 15 + e) * 1024; s = s + *(const f32x4*)(src + 4 * c4); }
            }
            const f32x4 cur = *(const f32x4*)(UPOOL + (size_t)m * 1024 + 4 * c4);
            st_bf4(POOLED + (size_t)m * 1024 + 4 * c4, s / cnt - cur);
        }
        for (int it = bx * 512 + tid; it < 4 * 15 * 256; it += G * 512) { const int c4 = it & 255, i = (it >> 8) % 15, b = it / (15 * 256);
            *(f32x4*)(dout + O_POOLP + (size_t)(b * 15 + i) * 1024 + 4 * c4) = *(const f32x4*)(UPOOL + (size_t)(b * 2048 + 2033 + i) * 1024 + 4 * c4); }
        for (int it = bx * 512 + tid; it < 128 * 15 * 256; it += G * 512) { const int c4 = it & 255, i = (it >> 8) % 15, b = it / (15 * 256); const int e = 8 + i;
            const float* src = (e >= 15) ? UPOOL + (size_t)(MP + b * 8 + (e - 15)) * 1024 : spool + (size_t)(b * 15 + e) * 1024;
            *(f32x4*)(dout + O_POOLS + (size_t)(b * 15 + i) * 1024 + 4 * c4) = *(const f32x4*)(src + 4 * c4); }
    }
    {
        const int tid = opq(tid0), lane = tid & 63; (void)tid; (void)lane;
        LAS float* qs = (LAS float*)lds; LAS float* Ss = (LAS float*)(lds + 8192); LAS float* Pm = (LAS float*)(lds + 16384);
        const float* ck = args.in[I_CK]; const float* cv = args.in[I_CV];
        for (int unit = bx; unit < 512; unit += G) {
            const int b = unit >> 2, h = unit & 3;
            { const int idx = tid * 4, i = idx >> 8, d = idx & 255; const f32x4 qv = ld_bf4(QB + (size_t)(MP + b * 8 + i) * 1024 + h * 256 + d); *(LAS f32x4*)(qs + idx) = qv; }
            __syncthreads();
            f32x4 qv[8];
#pragma unroll
            for (int i = 0; i < 8; ++i) qv[i] = *(const LAS f32x4*)(qs + i * 256 + 4 * lane);
            {
                const float* kp = ck + ((size_t)(b * 256 + wave * 32) * 4 + h) * 256 + 4 * lane;
                f32x4 kb[2][8];
#pragma unroll
                for (int r = 0; r < 8; ++r) kb[0][r] = *(const f32x4*)(kp + (size_t)r * 1024);
#pragma unroll
                for (int bt = 0; bt < 4; ++bt) {
                    if (bt < 3) {
#pragma unroll
                        for (int r = 0; r < 8; ++r) kb[(bt + 1) & 1][r] = *(const f32x4*)(kp + (size_t)((bt + 1) * 8 + r) * 1024);
                    }
#pragma unroll
                    for (int r = 0; r < 8; ++r) {
                        const f32x4 kv = kb[bt & 1][r]; const int mem = wave * 32 + bt * 8 + r;
                        float p[8];
#pragma unroll
                        for (int i = 0; i < 8; ++i) p[i] = (qv[i][0] * kv[0] + qv[i][1] * kv[1]) + (qv[i][2] * kv[2] + qv[i][3] * kv[3]);
                        const bool h5 = (lane & 32) != 0, h4 = (lane & 16) != 0, h3 = (lane & 8) != 0;
                        float r4[4], r2[2], r1;
#pragma unroll
                        for (int j = 0; j < 4; ++j) { const float snd = h5 ? p[j] : p[j + 4], kp_ = h5 ? p[j + 4] : p[j]; r4[j] = kp_ + __shfl_xor(snd, 32); }
#pragma unroll
                        for (int j = 0; j < 2; ++j) { const float snd = h4 ? r4[j] : r4[j + 2], kp_ = h4 ? r4[j + 2] : r4[j]; r2[j] = kp_ + __shfl_xor(snd, 16); }
                        { const float snd = h3 ? r2[0] : r2[1], kp_ = h3 ? r2[1] : r2[0]; r1 = kp_ + __shfl_xor(snd, 8); }
                        r1 += __shfl_xor(r1, 4); r1 += __shfl_xor(r1, 2); r1 += __shfl_xor(r1, 1);
                        const int qi = (h5 ? 4 : 0) + (h4 ? 2 : 0) + (h3 ? 1 : 0);
                        if ((lane & 7) == 0) Ss[qi * 256 + mem] = r1 * 0.0625f;
                    }
                }
            }
            __syncthreads();
            { const f32x4 s4 = *(const LAS f32x4*)(Ss + wave * 256 + 4 * lane); const float mx = wave_max(fmaxf(fmaxf(s4[0], s4[1]), fmaxf(s4[2], s4[3])));
              f32x4 e; e[0] = __expf(s4[0] - mx); e[1] = __expf(s4[1] - mx); e[2] = __expf(s4[2] - mx); e[3] = __expf(s4[3] - mx);
              const float inv = 1.0f / wave_sum((e[0] + e[1]) + (e[2] + e[3]));
#pragma unroll
              for (int j = 0; j < 4; ++j) Pm[(4 * lane + j) * 8 + wave] = e[j] * inv; }
            __syncthreads();
            {
                const float* vp = cv + ((size_t)(b * 256 + wave * 32) * 4 + h) * 256 + 4 * lane;
                f32x4 o[8];
#pragma unroll
                for (int i = 0; i < 8; ++i) o[i] = (f32x4){0.f, 0.f, 0.f, 0.f};
                f32x4 vb[2][8];
#pragma unroll
                for (int r = 0; r < 8; ++r) vb[0][r] = *(const f32x4*)(vp + (size_t)r * 1024);
#pragma unroll
                for (int bt = 0; bt < 4; ++bt) {
                    if (bt < 3) {
#pragma unroll
                        for (int r = 0; r < 8; ++r) vb[(bt + 1) & 1][r] = *(const f32x4*)(vp + (size_t)((bt + 1) * 8 + r) * 1024);
                    }
#pragma unroll
                    for (int r = 0; r < 8; ++r) { const int mem = wave * 32 + bt * 8 + r; const f32x4 v = vb[bt & 1][r];
                        const f32x4 p0 = *(const LAS f32x4*)(Pm + mem * 8), p1 = *(const LAS f32x4*)(Pm + mem * 8 + 4);
#pragma unroll
                        for (int i = 0; i < 4; ++i) { o[i] = o[i] + v * p0[i]; o[4 + i] = o[4 + i] + v * p1[i]; } }
                }
                LAS float* Op = (LAS float*)(lds + 32768);
#pragma unroll
                for (int i = 0; i < 8; ++i) *(LAS f32x4*)(Op + (wave * 8 + i) * 256 + 4 * lane) = o[i];
                __syncthreads();
                { const int idx = tid * 4, i = idx >> 8, d = idx & 255; f32x4 s = {0.f, 0.f, 0.f, 0.f};
#pragma unroll
                  for (int w2 = 0; w2 < 8; ++w2) s = s + *(const LAS f32x4*)(Op + (w2 * 8 + i) * 256 + d);
                  st_bf4(ACAT + (size_t)(MP + b * 8 + i) * 3072 + 2048 + h * 256 + d, s); }
            }
            __syncthreads();
        }
    }
    grid.sync();

    {
        pg8::MultiOrder<1> S; S.G = G; S.c = bx; S.nt = 16;
        S.s[0] = pg8::Sub{(const char*)ZG, (const char*)GLUW_T, 36, 4, 1, 0, 256ll * 1024 * 2, 0, 0, 256ll * 1024 * 2};
        EpiBf<2> E{ACAT + 1024, 3072, args.in[I_GLUB], ZG, 1024};
        pg8::gemm_phase<EpiBf<2>, pg8::MultiOrder<1>, true, true>(lds, pg8::Gemm{1024, 1024, 1024}, S, E);
    }
    {
        pg8::MultiOrder<1> S; S.G = G; S.c = (bx + 112) % G; S.nt = 4;
        S.s[0] = pg8::Sub{(const char*)POOLED, (const char*)POOLW_T, 36, 4, 1, 0, 256ll * 1024 * 2, 256ll * 2, 0, 256ll * 2};
        EpiBf<1> E{ACAT, 3072, args.in[I_PSCALE], nullptr, 0};
        pg8::gemm_phase<EpiBf<1>, pg8::MultiOrder<1>, true, true>(lds, pg8::Gemm{256, 1024, 1024}, S, E);
    }
    {
        pg8::MultiOrder<1> S; S.G = G; S.c = (bx + 112) % G; S.nt = 4;
        S.s[0] = pg8::Sub{(const char*)PB, (const char*)VT, 32, 4, 8, 0, 256ll * 1024 * 2, 256ll * 2, 256ll * 1024 * 2, 256ll * 2};
        EpiBf<0> E{ACAT + 2048, 3072, nullptr, nullptr, 0};
        pg8::gemm_phase<EpiBf<0>, pg8::MultiOrder<1>, true, true>(lds, pg8::Gemm{256, 1024, 1024}, S, E);
    }
    grid.sync();

    {
        pg8::MultiOrder<1> S; S.G = G; S.c = bx; S.nt = 48;
        S.s[0] = pg8::Sub{(const char*)ACAT, (const char*)BCAT, 36, 8, 1, 0, 256ll * 3072 * 2, 0, 0, 256ll * 3072 * 2};
        EpiMergeK E{GATES, MERGEDB};
        pg8::gemm_phase<EpiMergeK, pg8::MultiOrder<1>, true, true>(lds, pg8::Gemm{3072, 3072, 3072}, S, E);
    }
    grid.sync();

    {
        pg8::StreamK<1, 7> S; S.nt = 32; S.seq = 5; S.ackseq = 0; S.split = SPLIT_P5; S.flags = (unsigned*)(ws + WS_FLAGS); S.acks = (unsigned*)(ws + WS_ACKS); S.slab = ws + WS_SLAB; S.init(G, bx, 288);
        S.s[0] = pg8::Sub{(const char*)MERGEDB, (const char*)WOUT_T, 36, 8, 1, 0, 256ll * 2048 * 2, 0, 0, 256ll * 2048 * 2};
        EpiResid E{args.in[I_XP], args.in[I_XS], MP, X1};
        pg8::gemm_phase<EpiResid, pg8::StreamK<1, 7>, true, true>(lds, pg8::Gemm{2048, 2048, 2048}, S, E);
    }
    grid.sync();

    { const int tid = opq(tid0), lane = tid & 63; (void)tid; (void)lane;
      for (int m = gw; m < MT; m += NGW) rms_row<true>(X1 + (size_t)m * DM, args.in[I_N2G], XN + (size_t)m * DM, lane); }
    grid.sync();

    {
        pg8::StreamK<1, 1> S; S.nt = 32; S.seq = 6; S.ackseq = 0; S.split = SPLIT_P6; S.flags = (unsigned*)(ws + WS_FLAGS); S.acks = (unsigned*)(ws + WS_ACKS); S.slab = ws + WS_SLAB; S.init(G, bx, 1152);
        S.s[0] = pg8::Sub{(const char*)XN, (const char*)W1_T, 36, 32, 1, 0, 256ll * 2048 * 2, 0, 0, 256ll * 2048 * 2};
        EpiBf<3> E{HB, 8192, nullptr, nullptr, 0};
        pg8::gemm_phase<EpiBf<3>, pg8::StreamK<1, 1>, true, true>(lds, pg8::Gemm{2048, 2048, 2048}, S, E);
    }
    grid.sync();

    {
        pg8::StreamK<1, 7> S; S.nt = 128; S.seq = 7; S.ackseq = 0; S.split = SPLIT_P7; S.flags = (unsigned*)(ws + WS_FLAGS); S.acks = (unsigned*)(ws + WS_ACKS); S.slab = ws + WS_SLAB; S.init(G, bx, 288);
        S.s[0] = pg8::Sub{(const char*)HB, (const char*)W2_T, 36, 8, 1, 0, 256ll * 8192 * 2, 0, 0, 256ll * 8192 * 2};
        EpiResid E{X1, X1, MT, X2};
        pg8::gemm_phase<EpiResid, pg8::StreamK<1, 7>, true, true>(lds, pg8::Gemm{8192, 8192, 8192}, S, E);
    }
    grid.sync();

    { const int tid = opq(tid0), lane = tid & 63; (void)tid; (void)lane;
      for (int m = gw; m < MT; m += NGW) rms_row<false>(X2 + (size_t)m * DM, args.in[I_FNG], dout + (size_t)m * DM, lane); }
}

extern "C" void kernel_launch(void* const* d_in, const int* in_sizes, int n_in, void* d_out, int out_size, void* d_ws, size_t ws_size, hipStream_t stream) {
    static int grid = 0;
    if (grid == 0) {
        if (n_in != N_IN || ws_size < WS_END) { fprintf(stderr, "kernel_launch: expected %d inputs and >= %zu bytes of workspace; got %d, %zu; nothing launched\n", (int)N_IN, (size_t)WS_END, n_in, ws_size); grid = -1; return; }
        int dev = 0, cus = 0, per_cu = 0;
        if (hipGetDevice(&dev) != hipSuccess || hipDeviceGetAttribute(&cus, hipDeviceAttributeMultiprocessorCount, dev) != hipSuccess) { fprintf(stderr, "kernel_launch: device query failed\n"); grid = -1; return; }
        if (hipFuncSetAttribute((const void*)mega_fwd, hipFuncAttributeMaxDynamicSharedMemorySize, LDS_BYTES) != hipSuccess) { fprintf(stderr, "kernel_launch: hipFuncSetAttribute failed\n"); grid = -1; return; }
        if (hipOccupancyMaxActiveBlocksPerMultiprocessor(&per_cu, (const void*)mega_fwd, 512, LDS_BYTES) != hipSuccess || per_cu < 1) { fprintf(stderr, "kernel_launch: occupancy query says %d blocks per CU\n", per_cu); per_cu = 1; }
        (void)hipGetLastError();
        grid = cus;
        if (grid > 256) grid = 256;
        if (grid != 256) fprintf(stderr, "kernel_launch: %d workgroups; the stream-K chunking assumes 256 (chunk >= one unit)\n", grid);
        if (grid < 144) fprintf(stderr, "kernel_launch: only %d CUs; the one-unit-per-workgroup attention phase needs >= 144\n", grid);
    }
    if (grid < 0) return;
    if (hipMemsetAsync(d_ws, 0, 4096, stream) != hipSuccess) { fprintf(stderr, "kernel_launch: hipMemsetAsync failed\n"); return; }
    Args a{};
    for (int i = 0; i < N_IN; ++i) a.in[i] = (const float*)d_in[i];
    a.out = (float*)d_out; a.ws = (unsigned char*)d_ws;
    void* kargs[] = {&a};
    hipError_t e = hipLaunchCooperativeKernel((const void*)mega_fwd, dim3(grid), dim3(512), kargs, LDS_BYTES, stream);
    if (e != hipSuccess) fprintf(stderr, "kernel_launch: cooperative launch failed: %s (grid %d)\n", hipGetErrorString(e), grid);
}
```

```cpp
#include <hip/hip_runtime.h>
#include <hip/hip_cooperative_groups.h>
#include <cstdio>
#include <cstdint>
namespace cg = cooperative_groups;

namespace pg8 {
#define PG8_LAS __attribute__((address_space(3)))
typedef unsigned short bf16_t;
typedef short bf16x8 __attribute__((ext_vector_type(8)));
typedef float f32x4 __attribute__((ext_vector_type(4)));
typedef unsigned u32x4 __attribute__((ext_vector_type(4)));
typedef unsigned u32x2 __attribute__((ext_vector_type(2)));
constexpr int BM = 256, BK = 64, HALF = 128, HTB = HALF * BK * 2, STAGE_BYTES = 8 * HTB, NXCD = 8, WGM = 8;

__host__ __device__ __forceinline__ int lds_byte(int r, int c) { const int st = (r >> 4) * 2 + (c >> 5), rr = r & 15, cc = c & 31, ob = rr * 64 + cc * 2; return st * 1024 + (ob ^ (((ob >> 9) & 1) << 5)); }
__host__ __device__ __forceinline__ void stage_rc(int b, int& R, int& C) { const int st = b / 1024, sb = b % 1024, swz = sb ^ (((sb >> 9) & 1) << 5); R = (st >> 1) * 16 + swz / 64; C = (st & 1) * 32 + (swz % 64) / 2; }
__host__ __device__ __forceinline__ int perm32(int rho) { const int n = rho >> 4, i = rho & 15; return 8 * (i >> 2) + 4 * n + (i & 3); }

struct Unit { int pm, pn, g, nt, kind, peer, np; const char* a; const char* b; };
struct Gemm { int K, lda, ldb; };
struct Sub { const char* A; const char* B; int nM, nN, b_div, pad; long long a_pm, a_pn, b_pm, b_pn; };
template <int NS> struct MultiOrder {
    static constexpr bool STREAMK = false;
    Sub s[NS]; int G, c, nt;
    __device__ __forceinline__ bool next(int i, Unit& u) const {
        long long L = (long long)i * G + c;
#pragma unroll
        for (int k = 0; k < NS; ++k) {
            const int nM = s[k].nM, nN = s[k].nN, nwg = nM * nN;
            if (L < nwg) {
                int wgid = (int)L; { const int q = nwg / NXCD, r = nwg % NXCD, xcd = wgid % NXCD, off = wgid / NXCD; wgid = (xcd < r ? xcd * (q + 1) : r * (q + 1) + (xcd - r) * q) + off; }
                const int nig = WGM * nN, gid = wgid / nig, fm = gid * WGM, gsz = (nM - fm) < WGM ? (nM - fm) : WGM;
                u.pm = fm + ((wgid % nig) % gsz); u.pn = (wgid % nig) / gsz; u.g = k; u.nt = s[k].pad ? s[k].pad : nt; u.kind = 0; u.peer = 0; u.np = 0;
                u.a = s[k].A + u.pm * s[k].a_pm + u.pn * s[k].a_pn;
                u.b = s[k].B + (u.pm / s[k].b_div) * s[k].b_pm + u.pn * s[k].b_pn;
                return true;
            }
            L -= nwg;
        }
        return false;
    }
    __device__ __forceinline__ void a_ready(const Unit&) const {}
    __device__ __forceinline__ void done(const Unit&) const {}
};

template <int NS, int NP> struct StreamK {
    static constexpr bool STREAMK = true; static constexpr int NPART = NP;
    Sub s[NS]; int nt, G, c, R, ch, U; bool split = true; unsigned seq, ackseq; unsigned* flags; unsigned* acks; unsigned char* slab;
#ifndef SK_NOSPLIT
#define SK_NOSPLIT 0
#endif
    __device__ __forceinline__ void init(int G_, int bx, int total_units) { G = G_; c = bx; U = total_units; R = U / G; ch = ((U - R * G) * nt) / G; if (SK_NOSPLIT || !split) { R = (U + G - 1) / G; ch = 0; } }
    __device__ __forceinline__ void map(int L0, Unit& u, int kt0) const {
        int L = L0;
#pragma unroll
        for (int k = 0; k < NS; ++k) {
            const int nM = s[k].nM, nN = s[k].nN, nwg = nM * nN;
            if (L < nwg || k == NS - 1) {
                int wgid = L; { const int q = nwg / NXCD, r = nwg % NXCD, xcd = wgid % NXCD, off = wgid / NXCD; wgid = (xcd < r ? xcd * (q + 1) : r * (q + 1) + (xcd - r) * q) + off; }
                const int nig = WGM * nN, gid = wgid / nig, fm = gid * WGM, gsz = (nM - fm) < WGM ? (nM - fm) : WGM;
                u.pm = fm + ((wgid % nig) % gsz); u.pn = (wgid % nig) / gsz; u.g = k;
                u.a = s[k].A + u.pm * s[k].a_pm + u.pn * s[k].a_pn + (long long)kt0 * (BK * 2);
                u.b = s[k].B + (u.pm / s[k].b_div) * s[k].b_pm + u.pn * s[k].b_pn + (long long)kt0 * (BK * 2);
                return;
            }
            L -= nwg;
        }
    }
    __device__ __forceinline__ bool next(int i, Unit& u) const {
        if (i < R) { if (i * G + c >= U) return false; u.nt = nt; u.kind = 0; u.peer = 0; u.np = 0; map(i * G + c, u, 0); return true; }
        if (ch == 0) return false;
        const int j = i - R, lb = ch * c, le = lb + ch, un = lb / nt + j, us = un * nt; const int st = (j == 0) ? lb : us; const int en = (le < us + nt) ? le : us + nt;
        if (st >= en) return false;
        const int len = en - st;
        u.nt = len; u.peer = c; u.np = 0;
        if (len == nt) u.kind = 0; else if (st != us) u.kind = 1; else { u.kind = 2; u.np = (nt - len + ch - 1) / ch; }
        map(R * G + un, u, st - us);
        return true;
    }
    __device__ __forceinline__ void a_ready(const Unit&) const {}
    __device__ __forceinline__ void done(const Unit&) const {}
};
__device__ __forceinline__ unsigned cvt_pk_bf16(float lo, float hi) { unsigned r; asm volatile("v_cvt_pk_bf16_f32 %0, %1, %2" : "=v"(r) : "v"(lo), "v"(hi)); return r; }

template <class Epi, class Sched, bool ALIGN_EPI = false, bool SP2 = false>
__device__ __forceinline__ void gemm_phase(PG8_LAS unsigned char* lds, const Gemm g, const Sched& S, const Epi& E) {
    int tid_ = threadIdx.x; asm volatile("" : "+v"(tid_));
    const int tid = tid_, wid = __builtin_amdgcn_readfirstlane(tid >> 6), lane = tid & 63, wr = wid >> 2, wc = wid & 3, fr = lane & 15, fq = lane >> 4;
    (void)g.K;
    unsigned voffA[2], voffB[2];
#pragma unroll
    for (int i = 0; i < 2; ++i) { int R, C; stage_rc(tid * 16 + i * 8192, R, C); const int Rb = Epi::PERM ? ((R & ~31) + perm32(R & 31)) : R;
        voffA[i] = (unsigned)(R * g.lda + C) * 2u; voffB[i] = (unsigned)(Rb * g.ldb + C) * 2u; }
    const size_t kstep = (size_t)(BK * 2);
    const size_t hstepA = (size_t)HALF * g.lda * 2, hstepB = (size_t)HALF * g.ldb * 2;
    const unsigned ldsw = (unsigned)wid * 1024u;
    const int aoff = lds_byte(wr * 64 + fr, fq * 8), boff = lds_byte(wc * 32 + fr, fq * 8);
#define PG8_SA(b, h) (((b) * 2 + (h)) * HTB)
#define PG8_SB(b, h) ((4 + (b) * 2 + (h)) * HTB)
#define PG8_STAGE(bufoff, gbase, voff) do { _Pragma("unroll") for (int _i = 0; _i < 2; ++_i) \
        __builtin_amdgcn_global_load_lds((const unsigned*)((const char*)(gbase) + (voff)[_i]), (PG8_LAS unsigned*)(lds + (bufoff) + ldsw + _i * 8192), 16, 0, 0); } while (0)
#define PG8_LDA(dst, b, h) do { _Pragma("unroll") for (int m = 0; m < 4; ++m) _Pragma("unroll") for (int k = 0; k < 2; ++k) dst[m][k] = *(const PG8_LAS bf16x8*)(lds + PG8_SA(b, h) + aoff + m * 2048 + k * 1024); } while (0)
#define PG8_LDB(dst, b, h) do { _Pragma("unroll") for (int n = 0; n < 2; ++n) _Pragma("unroll") for (int k = 0; k < 2; ++k) dst[n][k] = *(const PG8_LAS bf16x8*)(lds + PG8_SB(b, h) + boff + n * 2048 + k * 1024); } while (0)
#define PG8_MMA(ai, bj, At, Bt) do { __builtin_amdgcn_s_setprio(1); _Pragma("unroll") for (int m = 0; m < 4; ++m) _Pragma("unroll") for (int n = 0; n < 2; ++n) _Pragma("unroll") for (int k = 0; k < 2; ++k) \
        acc[ai][bj][m][n] = __builtin_amdgcn_mfma_f32_16x16x32_bf16(Bt[n][k], At[m][k], acc[ai][bj][m][n], 0, 0, 0); __builtin_amdgcn_s_setprio(0); } while (0)
#define PG8_WAIT_V(n) asm volatile("s_waitcnt vmcnt(" #n ")" ::: "memory")
#define PG8_WAIT_L(n) asm volatile("s_waitcnt lgkmcnt(" #n ")" ::: "memory")
#define PG8_BAR __builtin_amdgcn_s_barrier()
#define PG8_SCHED __builtin_amdgcn_sched_barrier(0)
    Unit cur, nxt; int ui = 0;
    if (!S.next(0, cur)) return;
    f32x4 acc[2][2][4][2];
#pragma unroll
    for (int a = 0; a < 2; ++a)
#pragma unroll
        for (int b = 0; b < 2; ++b)
#pragma unroll
            for (int m = 0; m < 4; ++m)
#pragma unroll
                for (int n = 0; n < 2; ++n) acc[a][b][m][n] = (f32x4){0.f, 0.f, 0.f, 0.f};
    bf16x8 At[4][2], B0[2][2], B1[2][2];
    const char* cA = cur.a; const char* cB = cur.b;
    S.a_ready(cur);
    if constexpr (SP2) {
        PG8_STAGE(PG8_SB(0, 0), cB, voffB); PG8_STAGE(PG8_SB(0, 1), cB + hstepB, voffB); PG8_STAGE(PG8_SA(0, 0), cA, voffA); PG8_STAGE(PG8_SA(0, 1), cA + hstepA, voffA);
        if (wr == 1) PG8_BAR;
        PG8_WAIT_V(2); PG8_BAR;
        PG8_STAGE(PG8_SB(1, 0), cB + kstep, voffB); PG8_STAGE(PG8_SA(1, 0), cA + kstep, voffA); PG8_STAGE(PG8_SB(1, 1), cB + hstepB + kstep, voffB);
        PG8_WAIT_V(6); PG8_BAR;
    } else {
        PG8_STAGE(PG8_SB(0, 0), cB, voffB); PG8_STAGE(PG8_SA(0, 0), cA, voffA); PG8_STAGE(PG8_SB(0, 1), cB + hstepB, voffB); PG8_STAGE(PG8_SA(0, 1), cA + hstepA, voffA);
        if (wr == 1) PG8_BAR;
        PG8_WAIT_V(4); PG8_BAR;
        PG8_STAGE(PG8_SB(1, 0), cB + kstep, voffB); PG8_STAGE(PG8_SA(1, 0), cA + kstep, voffA); PG8_STAGE(PG8_SB(1, 1), cB + hstepB + kstep, voffB);
        PG8_WAIT_V(6); PG8_BAR;
    }
    for (;;) {
        const bool has_next = S.next(ui + 1, nxt);
        const char* nA = has_next ? nxt.a : cA; const char* nB = has_next ? nxt.b : cB;
        const int nt = cur.nt;
        for (int t = 0; t < nt; t += 2) {
            if constexpr (Epi::HOOK) { if (t == 16 || t == 32) E.hook(acc, cur, wr, wc, fr, fq, t >> 4); }
            const bool last = (t == nt - 2);
            const char* a1 = cA + (size_t)(t + 1) * kstep;
            const char* a2 = last ? nA : cA + (size_t)(t + 2) * kstep; const char* b2 = last ? nB : cB + (size_t)(t + 2) * kstep;
            const char* a3 = a2 + kstep; const char* b3 = b2 + kstep;
            if (last && has_next) S.a_ready(nxt);
            if constexpr (SP2) {
            PG8_LDB(B0, 0, 0); PG8_LDB(B1, 0, 1); PG8_SCHED; PG8_LDA(At, 0, 0); PG8_STAGE(PG8_SA(1, 1), a1 + hstepA, voffA);
            PG8_WAIT_V(8); PG8_WAIT_L(0); PG8_BAR; PG8_MMA(0, 0, At, B0); PG8_MMA(0, 1, At, B1); PG8_BAR; PG8_SCHED;
            PG8_LDA(At, 0, 1); PG8_STAGE(PG8_SB(0, 0), b2, voffB); PG8_STAGE(PG8_SB(0, 1), b2 + hstepB, voffB); PG8_STAGE(PG8_SA(0, 0), a2, voffA);
            PG8_WAIT_V(8); PG8_WAIT_L(0); PG8_BAR; PG8_MMA(1, 0, At, B0); PG8_MMA(1, 1, At, B1); PG8_BAR; PG8_SCHED;
            PG8_LDB(B0, 1, 0); PG8_LDB(B1, 1, 1); PG8_SCHED; PG8_LDA(At, 1, 0); PG8_STAGE(PG8_SA(0, 1), a2 + hstepA, voffA);
            PG8_WAIT_V(8); PG8_WAIT_L(0); PG8_BAR; PG8_MMA(0, 0, At, B0); PG8_MMA(0, 1, At, B1); PG8_BAR; PG8_SCHED;
            PG8_LDA(At, 1, 1); PG8_STAGE(PG8_SB(1, 0), b3, voffB); PG8_STAGE(PG8_SB(1, 1), b3 + hstepB, voffB); PG8_STAGE(PG8_SA(1, 0), a3, voffA);
            PG8_WAIT_V(8); PG8_WAIT_L(0); PG8_BAR; PG8_MMA(1, 0, At, B0); PG8_MMA(1, 1, At, B1); PG8_BAR; PG8_SCHED;
            } else {
            PG8_LDB(B0, 0, 0); PG8_SCHED; PG8_LDA(At, 0, 0); PG8_STAGE(PG8_SA(1, 1), a1 + hstepA, voffA);
            PG8_WAIT_L(8); PG8_BAR; PG8_WAIT_L(0); PG8_MMA(0, 0, At, B0); PG8_BAR; PG8_SCHED;
            PG8_LDB(B1, 0, 1); PG8_STAGE(PG8_SB(0, 0), b2, voffB);
            PG8_BAR; PG8_WAIT_L(0); PG8_MMA(0, 1, At, B1); PG8_BAR;
            PG8_LDA(At, 0, 1); PG8_STAGE(PG8_SA(0, 0), a2, voffA);
            PG8_BAR; PG8_WAIT_L(0); PG8_MMA(1, 0, At, B0); PG8_BAR; PG8_SCHED;
            PG8_STAGE(PG8_SB(0, 1), b2 + hstepB, voffB);
            PG8_WAIT_V(6); PG8_BAR; PG8_MMA(1, 1, At, B1); PG8_BAR;
            PG8_LDB(B0, 1, 0); PG8_SCHED; PG8_LDA(At, 1, 0); PG8_STAGE(PG8_SA(0, 1), a2 + hstepA, voffA);
            PG8_WAIT_L(8); PG8_BAR; PG8_WAIT_L(0); PG8_MMA(0, 0, At, B0); PG8_BAR; PG8_SCHED;
            PG8_LDB(B1, 1, 1); PG8_STAGE(PG8_SB(1, 0), b3, voffB);
            PG8_BAR; PG8_WAIT_L(0); PG8_MMA(0, 1, At, B1); PG8_BAR;
            PG8_LDA(At, 1, 1); PG8_STAGE(PG8_SA(1, 0), a3, voffA);
            PG8_BAR; PG8_WAIT_L(0); PG8_MMA(1, 0, At, B0); PG8_BAR; PG8_SCHED;
            PG8_STAGE(PG8_SB(1, 1), b3 + hstepB, voffB);
            PG8_WAIT_V(6); PG8_BAR; PG8_MMA(1, 1, At, B1); PG8_BAR;
            }
        }
        if constexpr (ALIGN_EPI) { if (wr == 0) PG8_BAR; }
        if constexpr (!Epi::AFTER_DRAIN) {
            if constexpr (Sched::STREAMK) {
                static_assert(ALIGN_EPI, "stream-K pieces need both half-workgroups aligned at the epilogue");
                int tid_e = tid; asm volatile("" : "+v"(tid_e));
                if (cur.kind == 1) {
                    if (S.ackseq) { if (tid == 0) { unsigned sp = 0; while (__hip_atomic_load(S.acks + cur.peer, __ATOMIC_RELAXED, __HIP_MEMORY_SCOPE_AGENT) < S.ackseq && ++sp < (1u << 22)) __builtin_amdgcn_s_sleep(2); } PG8_BAR; }
                    f32x4* sl = (f32x4*)(S.slab + (size_t)cur.peer * 262144) + tid_e;
#pragma unroll
                    for (int a = 0; a < 2; ++a)
#pragma unroll
                        for (int b = 0; b < 2; ++b)
#pragma unroll
                            for (int m = 0; m < 4; ++m)
#pragma unroll
                                for (int n = 0; n < 2; ++n) { f32x4* sp_ = sl + (((a * 2 + b) * 4 + m) * 2 + n) * 512; asm volatile("global_store_dwordx4 %0, %1, off sc1\n\ts_nop 1" :: "v"(sp_), "v"(acc[a][b][m][n]) : "memory"); }
                    asm volatile("s_waitcnt vmcnt(0)" ::: "memory");
                    PG8_BAR;
                    if (tid == 0) __hip_atomic_store(S.flags + cur.peer, S.seq, __ATOMIC_RELAXED, __HIP_MEMORY_SCOPE_AGENT);
                } else if (cur.kind == 2) {
                    if (tid == 0) { for (int p = 1; p <= cur.np; ++p) { unsigned sp = 0; while (__hip_atomic_load(S.flags + cur.peer + p, __ATOMIC_RELAXED, __HIP_MEMORY_SCOPE_AGENT) < S.seq && ++sp < (1u << 22)) __builtin_amdgcn_s_sleep(2); }
                        __builtin_amdgcn_fence(__ATOMIC_ACQUIRE, "agent"); asm volatile("s_waitcnt vmcnt(0)" ::: "memory"); }
                    PG8_BAR; asm volatile("" ::: "memory");
                    E.template run<Sched::NPART>(acc, cur, wr, wc, fr, fq, (const f32x4*)(S.slab + (size_t)(cur.peer + 1) * 262144) + tid_e);
                    asm volatile("s_waitcnt vmcnt(0)" ::: "memory");
                    PG8_BAR;
                    if (tid == 0) { for (int p = 1; p <= cur.np; ++p) __hip_atomic_store(S.acks + cur.peer + p, S.seq, __ATOMIC_RELAXED, __HIP_MEMORY_SCOPE_AGENT); }
                } else { E.template run<0>(acc, cur, wr, wc, fr, fq, (const f32x4*)nullptr); }
            } else { E.template run<0>(acc, cur, wr, wc, fr, fq, (const f32x4*)nullptr); }
            S.done(cur); }
        if (!has_next) break;
#pragma unroll
        for (int a = 0; a < 2; ++a)
#pragma unroll
            for (int b = 0; b < 2; ++b)
#pragma unroll
                for (int m = 0; m < 4; ++m)
#pragma unroll
                    for (int n = 0; n < 2; ++n) acc[a][b][m][n] = (f32x4){0.f, 0.f, 0.f, 0.f};
        cur = nxt; cA = nA; cB = nB; ++ui;
        if constexpr (ALIGN_EPI) { if (wr == 1) PG8_BAR; }
    }
    PG8_WAIT_V(0);
    if constexpr (!ALIGN_EPI) { if (wr == 0) PG8_BAR; }
    PG8_BAR;
    if constexpr (Epi::AFTER_DRAIN) { E.fused(acc, cur, wr, wc, fr, fq, lds, wid, lane); S.done(cur); }
#undef PG8_SA
#undef PG8_SB
#undef PG8_STAGE
#undef PG8_LDA
#undef PG8_LDB
#undef PG8_MMA
#undef PG8_WAIT_V
#undef PG8_WAIT_L
#undef PG8_BAR
#undef PG8_SCHED
}
}

#define LAS __attribute__((address_space(3)))
typedef unsigned short bf16;
typedef float f32x4 __attribute__((ext_vector_type(4)));
typedef float f32x2 __attribute__((ext_vector_type(2)));
typedef unsigned u32x4 __attribute__((ext_vector_type(4)));
typedef unsigned u32x2 __attribute__((ext_vector_type(2)));
typedef short bf16x8 __attribute__((ext_vector_type(8)));
using pg8::cvt_pk_bf16;

constexpr int DM = 2048, MP = 8192, MS = 1024, MT = MP + MS;
constexpr int INW = 9216, DFF = 8192;
constexpr float EPS = 1e-6f;
constexpr size_t MiB = 1u << 20;
constexpr size_t WS_PAR = 1 * MiB;
constexpr size_t WS_WIN = 2 * MiB, WS_WKV = 40 * MiB, WS_POOLW = 48 * MiB, WS_GLUW = 49 * MiB, WS_PPROJ = 52 * MiB, WS_SPROJ = 56 * MiB, WS_XAWO = 60 * MiB;
constexpr size_t WS_WOUT = 64 * MiB, WS_W1 = 72 * MiB, WS_W2 = 104 * MiB;
constexpr int LDH = 8192;
constexpr size_t WS_XN = 136 * MiB, WS_MN = 172 * MiB;
constexpr size_t WS_UPOOL = 176 * MiB, WS_USSM = 212 * MiB, WS_X1 = 176 * MiB;
constexpr size_t WS_Q = 248 * MiB, WS_GATES = 266 * MiB, WS_KB = 374 * MiB, WS_VT = 376 * MiB;
constexpr size_t WS_POOLED = 378 * MiB, WS_ZG = 396 * MiB, WS_P = 414 * MiB, WS_ACAT = 448 * MiB;
constexpr size_t WS_MERGED = 484 * MiB, WS_X2 = 394 * MiB;
constexpr size_t WS_SLAB = 484 * MiB, WS_SLAB4 = 176 * MiB;
constexpr size_t WS_FLAGS = 0, WS_ACKS = 1024;
constexpr size_t WS_MERGEDB = 378 * MiB;
constexpr size_t WS_H = 248 * MiB;
constexpr size_t WS_END = 556 * MiB;
constexpr size_t PAR_AB = 0;
constexpr size_t PAR_BB = 32768;
constexpr size_t PAR_RSS = 921600;
constexpr size_t PAR_CMT = 32768 + 524288;
constexpr size_t O_YP = 0, O_YS = 16777216, O_POOLP = 18874368, O_REP = 18935808, O_IMP = 18952192, O_MK = 18968576, O_MV = 20017152, O_POOLS = 21065728, O_RES = 23031808, O_IMS = 23556096;
constexpr int LDS_BYTES = 147456;
#ifndef SPLIT_P1
#define SPLIT_P1 false
#endif
#ifndef SPLIT_P2
#define SPLIT_P2 false
#endif
#ifndef SPLIT_P5
#define SPLIT_P5 false
#endif
#ifndef SPLIT_P6
#define SPLIT_P6 false
#endif
#ifndef SPLIT_P7
#define SPLIT_P7 true
#endif

enum { I_XP = 0, I_XS, I_SPOOL, I_SRE, I_SIM, I_CK, I_CV, I_MEM, I_N1G, I_WIN, I_BGATE, I_POOLW, I_PSCALE, I_PPROJ, I_ARE, I_AIM, I_LOGDT, I_BRE, I_BIM, I_CRE, I_CIM, I_DSK, I_GLUW, I_GLUB, I_SPROJ, I_MNG, I_WK, I_WV, I_WO, I_WOUT, I_N2G, I_W1, I_W2, I_FNG, N_IN };
struct Args { const float* in[N_IN]; float* out; unsigned char* ws; };

__device__ __forceinline__ int opq(int v) { asm volatile("" : "+v"(v)); return v; }
__device__ __forceinline__ float wave_sum(float v) {
#pragma unroll
    for (int o = 1; o < 64; o <<= 1) v += __shfl_xor(v, o);
    return v;
}
__device__ __forceinline__ float wave_max(float v) {
#pragma unroll
    for (int o = 1; o < 64; o <<= 1) v = fmaxf(v, __shfl_xor(v, o));
    return v;
}
__device__ __forceinline__ float bf2f(unsigned short b) { return __uint_as_float((unsigned)b << 16); }
__device__ __forceinline__ unsigned short f2bf(float f) { return (unsigned short)(cvt_pk_bf16(f, 0.f) & 0xffffu); }
__device__ __forceinline__ f32x4 ld_bf4(const bf16* p) { const u32x2 w = *(const u32x2*)p; return (f32x4){__uint_as_float(w.x << 16), __uint_as_float(w.x & 0xffff0000u), __uint_as_float(w.y << 16), __uint_as_float(w.y & 0xffff0000u)}; }
__device__ __forceinline__ void st_bf4(bf16* p, f32x4 v) { u32x2 w; w.x = cvt_pk_bf16(v[0], v[1]); w.y = cvt_pk_bf16(v[2], v[3]); *(u32x2*)p = w; }
__device__ __forceinline__ float sigmoidf_(float x) { return 1.0f / (1.0f + __expf(-x)); }
__device__ __forceinline__ float gelu_tanh(float y) { const float z = 0.7978845608f * (y + 0.044715f * y * y * y); const float th = 1.0f - 2.0f / (__expf(2.0f * z) + 1.0f); return 0.5f * y * (1.0f + th); }

#define EPI_LOOP(body) _Pragma("unroll") for (int ai = 0; ai < 2; ++ai) _Pragma("unroll") for (int m = 0; m < 4; ++m) _Pragma("unroll") for (int bj = 0; bj < 2; ++bj) _Pragma("unroll") for (int n = 0; n < 2; ++n) { \
        const int row = r0 + ai * 128 + m * 16, col = c0 + bj * 128 + n * 16; f32x4 v = acc[ai][bj][m][n]; _Pragma("unroll") for (int p_ = 0; p_ < PART; ++p_) v = v + part[(size_t)p_ * 16384 + ((((ai * 2 + bj) * 4 + m) * 2 + n)) * 512]; body }

struct EpiIn {
    static constexpr bool PERM = false, AFTER_DRAIN = false, HOOK = false;
    float* upool; float* ussm; bf16* q; bf16* gates; const float* bgate; float* outk; bf16* kb; float* outv; bf16* vt;
    template <int PART> __device__ __forceinline__ void run(const f32x4 (&acc)[2][2][4][2], const pg8::Unit& u, int wr, int wc, int fr, int fq, const f32x4* part) const {
        const int r0 = u.pm * 256 + wr * 64 + fr, c0 = u.pn * 256 + wc * 32 + 4 * fq;
        if (u.g == 0) {
            if (u.pn < 8) { float* dst = (u.pn < 4) ? upool : ussm;
                EPI_LOOP( *(f32x4*)(dst + (size_t)row * 1024 + (col & 1023)) = v; )
            } else if (u.pn < 12) {
                EPI_LOOP( st_bf4(q + (size_t)row * 1024 + (col - 2048), v); )
            } else {
                EPI_LOOP( const f32x4 bg = *(const f32x4*)(bgate + (col - 3072)); f32x4 o; o[0] = sigmoidf_(v[0] + bg[0]); o[1] = sigmoidf_(v[1] + bg[1]); o[2] = sigmoidf_(v[2] + bg[2]); o[3] = sigmoidf_(v[3] + bg[3]);
                          st_bf4(gates + (size_t)row * 6144 + (col - 3072), o); )
            }
        } else if (u.g == 1) {
            EPI_LOOP( *(f32x4*)(outk + (size_t)row * 1024 + col) = v; st_bf4(kb + (size_t)row * 1024 + col, v); )
        } else {
            EPI_LOOP( outv[(size_t)(col + 0) * 1024 + row] = v[0]; outv[(size_t)(col + 1) * 1024 + row] = v[1]; outv[(size_t)(col + 2) * 1024 + row] = v[2]; outv[(size_t)(col + 3) * 1024 + row] = v[3];
                      st_bf4(vt + ((size_t)(u.pn * 256 + (row & 255))) * 1024 + u.pm * 256 + (col & 255), v); )
        }
    }
};

struct EpiSoftmax {
    static constexpr bool PERM = false, AFTER_DRAIN = true, HOOK = false;
    bf16* P;
    __device__ __forceinline__ void fused(f32x4 (&acc)[2][2][4][2], const pg8::Unit& u, int wr, int wc, int fr, int fq, PG8_LAS unsigned char* lds, int wid, int lane) const {
        const float sc = 0.0625f * 1.4426950408889634f;
        LAS f32x2* X = (LAS f32x2*)lds;
        float mloc[2][4];
#pragma unroll
        for (int ai = 0; ai < 2; ++ai)
#pragma unroll
            for (int m = 0; m < 4; ++m) {
                float mx = -3.0e38f;
#pragma unroll
                for (int bj = 0; bj < 2; ++bj)
#pragma unroll
                    for (int n = 0; n < 2; ++n) { const f32x4 x = acc[ai][bj][m][n]; mx = fmaxf(mx, fmaxf(fmaxf(x[0], x[1]), fmaxf(x[2], x[3]))); }
                mx = fmaxf(mx, __shfl_xor(mx, 16)); mx = fmaxf(mx, __shfl_xor(mx, 32));
                float s = 0.f;
#pragma unroll
                for (int bj = 0; bj < 2; ++bj)
#pragma unroll
                    for (int n = 0; n < 2; ++n) { f32x4 x = acc[ai][bj][m][n];
#pragma unroll
                        for (int e = 0; e < 4; ++e) { x[e] = __builtin_amdgcn_exp2f((x[e] - mx) * sc); s += x[e]; }
                        acc[ai][bj][m][n] = x; }
                s += __shfl_xor(s, 16); s += __shfl_xor(s, 32);
                mloc[ai][m] = mx;
                if (fq == 0) X[(ai * 128 + wr * 64 + m * 16 + fr) * 4 + wc] = (f32x2){mx, s};
            }
        asm volatile("s_waitcnt lgkmcnt(0)" ::: "memory"); __builtin_amdgcn_s_barrier(); asm volatile("" ::: "memory");
#pragma unroll
        for (int ai = 0; ai < 2; ++ai)
#pragma unroll
            for (int m = 0; m < 4; ++m) {
                const int rt = ai * 128 + wr * 64 + m * 16 + fr;
                const f32x2 a = X[rt * 4 + 0], b = X[rt * 4 + 1], c = X[rt * 4 + 2], d = X[rt * 4 + 3];
                const float M = fmaxf(fmaxf(a.x, b.x), fmaxf(c.x, d.x));
                const float tot = a.y * __builtin_amdgcn_exp2f((a.x - M) * sc) + b.y * __builtin_amdgcn_exp2f((b.x - M) * sc) + c.y * __builtin_amdgcn_exp2f((c.x - M) * sc) + d.y * __builtin_amdgcn_exp2f((d.x - M) * sc);
                const float f = __builtin_amdgcn_exp2f((mloc[ai][m] - M) * sc) / tot;
                bf16* rowp = P + (size_t)(u.pm * 256 + rt) * 1024 + u.pn * 256 + wc * 32 + 4 * fq;
#pragma unroll
                for (int bj = 0; bj < 2; ++bj)
#pragma unroll
                    for (int n = 0; n < 2; ++n) st_bf4(rowp + bj * 128 + n * 16, acc[ai][bj][m][n] * f);
            }
        asm volatile("s_waitcnt lgkmcnt(0)" ::: "memory"); __builtin_amdgcn_s_barrier(); asm volatile("" ::: "memory");
    }
};

template <int MODE> struct EpiBf {
    static constexpr bool PERM = false, AFTER_DRAIN = false, HOOK = false;
    bf16* out; int ld; const float* vec; const bf16* zg; int zld;
    template <int PART> __device__ __forceinline__ void run(const f32x4 (&acc)[2][2][4][2], const pg8::Unit& u, int wr, int wc, int fr, int fq, const f32x4* part) const {
        const int r0 = u.pm * 256 + wr * 64 + fr, c0 = u.pn * 256 + wc * 32 + 4 * fq;
        EPI_LOOP( f32x4 o = v;
            if (MODE == 1) { o = v * *(const f32x4*)(vec + col); }
            if (MODE == 2) { const f32x4 bb = *(const f32x4*)(vec + col); const f32x4 z = ld_bf4(zg + (size_t)row * zld + col);
                             o[0] = z[0] * sigmoidf_(v[0] + bb[0]); o[1] = z[1] * sigmoidf_(v[1] + bb[1]); o[2] = z[2] * sigmoidf_(v[2] + bb[2]); o[3] = z[3] * sigmoidf_(v[3] + bb[3]); }
            if (MODE == 3) { o[0] = fmaxf(v[0], 0.f); o[1] = fmaxf(v[1], 0.f); o[2] = fmaxf(v[2], 0.f); o[3] = fmaxf(v[3], 0.f); o = o * o; }
            st_bf4(out + (size_t)row * ld + col, o); )
    }
};

struct EpiMergeK {
    static constexpr bool PERM = false, AFTER_DRAIN = false, HOOK = true;
    const bf16* gates; bf16* mergedb;
    __device__ __forceinline__ void hook(f32x4 (&acc)[2][2][4][2], const pg8::Unit& u, int wr, int wc, int fr, int fq, int br) const {
        asm volatile("" : "+v"(fr), "+v"(fq));
        const int r0 = u.pm * 256 + wr * 64 + fr, c0 = u.pn * 256 + wc * 32 + 4 * fq;
#pragma unroll
        for (int ai = 0; ai < 2; ++ai)
#pragma unroll
            for (int m = 0; m < 4; ++m)
#pragma unroll
                for (int bj = 0; bj < 2; ++bj)
#pragma unroll
                    for (int n = 0; n < 2; ++n) { const int row = r0 + ai * 128 + m * 16, col = c0 + bj * 128 + n * 16; const bf16* gp = gates + (size_t)row * 6144 + (br - 1) * 2048 + col;
                        const f32x4 a = ld_bf4(gp), b = ld_bf4(gp + 2048); f32x4 v = acc[ai][bj][m][n];
#pragma unroll
                        for (int e = 0; e < 4; ++e) v[e] = v[e] * (a[e] * __builtin_amdgcn_rcpf(fmaxf(b[e], 1e-30f)));
                        acc[ai][bj][m][n] = v; if (bj == 1 && n == 1) asm volatile("" ::: "memory"); }
    }
    template <int PART> __device__ __forceinline__ void run(const f32x4 (&acc)[2][2][4][2], const pg8::Unit& u, int wr, int wc, int fr, int fq, const f32x4* part) const {
        const int r0 = u.pm * 256 + wr * 64 + fr, c0 = u.pn * 256 + wc * 32 + 4 * fq;
        EPI_LOOP( const f32x4 gt = ld_bf4(gates + (size_t)row * 6144 + 2 * 2048 + col); st_bf4(mergedb + (size_t)row * 2048 + col, gt * v); )
    }
};

struct EpiResid {
    static constexpr bool PERM = false, AFTER_DRAIN = false, HOOK = false;
    const float* base0; const float* base1; int split; float* out;
    template <int PART> __device__ __forceinline__ void run(const f32x4 (&acc)[2][2][4][2], const pg8::Unit& u, int wr, int wc, int fr, int fq, const f32x4* part) const {
        const int r0 = u.pm * 256 + wr * 64 + fr, c0 = u.pn * 256 + wc * 32 + 4 * fq;
        EPI_LOOP( const float* bp = (row < split) ? base0 + (size_t)row * 2048 + col : base1 + (size_t)(row - split) * 2048 + col;
            *(f32x4*)(out + (size_t)row * 2048 + col) = *(const f32x4*)bp + v; )
    }
};

struct EpiResidN {
    static constexpr bool PERM = false, AFTER_DRAIN = false, HOOK = false;
    const float* base0; const float* base1; int split; float* out; bf16* xg; const float* g2; float* rss;
    template <int PART> __device__ __forceinline__ void run(const f32x4 (&acc)[2][2][4][2], const pg8::Unit& u, int wr, int wc, int fr, int fq, const f32x4* part) const {
        const int r0 = u.pm * 256 + wr * 64 + fr, c0 = u.pn * 256 + wc * 32 + 4 * fq;
#pragma unroll
        for (int ai = 0; ai < 2; ++ai)
#pragma unroll
            for (int m = 0; m < 4; ++m) { const int row = r0 + ai * 128 + m * 16; float ss = 0.f;
#pragma unroll
                for (int bj = 0; bj < 2; ++bj)
#pragma unroll
                    for (int n = 0; n < 2; ++n) { const int col = c0 + bj * 128 + n * 16; f32x4 v = acc[ai][bj][m][n];
#pragma unroll
                        for (int p_ = 0; p_ < PART; ++p_) v = v + part[(size_t)p_ * 16384 + ((((ai * 2 + bj) * 4 + m) * 2 + n)) * 512];
                        const float* bp = (row < split) ? base0 + (size_t)row * 2048 + col : base1 + (size_t)(row - split) * 2048 + col;
                        const f32x4 x1 = *(const f32x4*)bp + v; *(f32x4*)(out + (size_t)row * 2048 + col) = x1;
                        ss += (x1[0] * x1[0] + x1[1] * x1[1]) + (x1[2] * x1[2] + x1[3] * x1[3]);
                        st_bf4(xg + (size_t)row * 2048 + col, x1 * *(const f32x4*)(g2 + col)); }
                ss += __shfl_xor(ss, 16); ss += __shfl_xor(ss, 32);
                if (fq == 0) atomicAdd(rss + row, ss); }
    }
};
struct EpiH {
    static constexpr bool PERM = false, AFTER_DRAIN = false, HOOK = false;
    bf16* out; int ld; const float* rss;
    template <int PART> __device__ __forceinline__ void run(const f32x4 (&acc)[2][2][4][2], const pg8::Unit& u, int wr, int wc, int fr, int fq, const f32x4* part) const {
        const int r0 = u.pm * 256 + wr * 64 + fr, c0 = u.pn * 256 + wc * 32 + 4 * fq;
        EPI_LOOP( const float rr = 1.0f / (rss[row] * (1.0f / 2048.0f) + EPS); f32x4 o; o[0] = fmaxf(v[0], 0.f); o[1] = fmaxf(v[1], 0.f); o[2] = fmaxf(v[2], 0.f); o[3] = fmaxf(v[3], 0.f); o = (o * o) * rr;
            st_bf4(out + (size_t)row * ld + col, o); )
    }
};
struct EpiP3 {
    static constexpr bool PERM = false, AFTER_DRAIN = false, HOOK = false;
    bf16* acat; const float* glub; const bf16* zg; const float* pscale;
    template <int PART> __device__ __forceinline__ void run(const f32x4 (&acc)[2][2][4][2], const pg8::Unit& u, int wr, int wc, int fr, int fq, const f32x4* part) const {
        const int r0 = u.pm * 256 + wr * 64 + fr, c0 = u.pn * 256 + wc * 32 + 4 * fq;
        if (u.g == 0) {
            EPI_LOOP( const f32x4 bb = *(const f32x4*)(glub + col); const f32x4 z = ld_bf4(zg + (size_t)row * 1024 + col); f32x4 o;
                o[0] = z[0] * sigmoidf_(v[0] + bb[0]); o[1] = z[1] * sigmoidf_(v[1] + bb[1]); o[2] = z[2] * sigmoidf_(v[2] + bb[2]); o[3] = z[3] * sigmoidf_(v[3] + bb[3]);
                st_bf4(acat + (size_t)row * 3072 + 1024 + col, o); )
        } else if (u.g == 1) {
            EPI_LOOP( st_bf4(acat + (size_t)row * 3072 + col, v * *(const f32x4*)(pscale + col)); )
        } else {
            EPI_LOOP( st_bf4(acat + (size_t)row * 3072 + 2048 + col, v); )
        }
    }
};

__device__ __forceinline__ void transpose_item(const float* W, int K, int N, bf16* WT, LAS float* scr, int item, int lane, int ldk = 0) {
    if (ldk == 0) ldk = K;
    const int nblk = N / 64, kb = item / nblk, nb = item % nblk, k0 = 64 * kb, n0 = 64 * nb;
    const float* src = W + (size_t)(k0 + (lane >> 4)) * N + n0 + 4 * (lane & 15);
    f32x4 t[16];
#pragma unroll
    for (int i = 0; i < 16; ++i) t[i] = *(const f32x4*)(src + (size_t)(4 * i) * N);
#pragma unroll
    for (int i = 0; i < 16; ++i) { LAS float* d = scr + (4 * i + (lane >> 4)) * 65 + 4 * (lane & 15); d[0] = t[i][0]; d[1] = t[i][1]; d[2] = t[i][2]; d[3] = t[i][3]; }
    asm volatile("s_waitcnt lgkmcnt(0)" ::: "memory");
    const int cc = lane & 7;
#pragma unroll
    for (int j = 0; j < 8; ++j) { const int n = 8 * j + (lane >> 3); const LAS float* s = scr + (8 * cc) * 65 + n;
        u32x4 o; o.x = cvt_pk_bf16(s[0 * 65], s[1 * 65]); o.y = cvt_pk_bf16(s[2 * 65], s[3 * 65]); o.z = cvt_pk_bf16(s[4 * 65], s[5 * 65]); o.w = cvt_pk_bf16(s[6 * 65], s[7 * 65]);
        *(u32x4*)(WT + (size_t)(n0 + n) * ldk + k0 + 8 * cc) = o; }
    asm volatile("s_waitcnt lgkmcnt(0)" ::: "memory");
}
template <bool TO_BF> __device__ __forceinline__ void rms_row(const float* xrow, const float* gw, void* orow, int lane) {
    f32x4 v[8]; float s = 0.f;
#pragma unroll
    for (int j = 0; j < 8; ++j) { v[j] = *(const f32x4*)(xrow + 4 * (lane + 64 * j)); s += (v[j][0] * v[j][0] + v[j][1] * v[j][1]) + (v[j][2] * v[j][2] + v[j][3] * v[j][3]); }
    s = wave_sum(s);
    const float r = 1.0f / sqrtf(s * (1.0f / 2048.0f) + EPS);
#pragma unroll
    for (int j = 0; j < 8; ++j) { const f32x4 g4 = *(const f32x4*)(gw + 4 * (lane + 64 * j)); const f32x4 o = (v[j] * r) * g4;
        if (TO_BF) st_bf4((bf16*)orow + 4 * (lane + 64 * j), o); else *(f32x4*)((float*)orow + 4 * (lane + 64 * j)) = o; }
}
__device__ __forceinline__ double dexp_(double x) {
    const double k = __builtin_rint(x * 1.4426950408889634); const double r = __builtin_fma(-k, 0.6931471805599453094, x);
    double p = 1.0;
#pragma unroll
    for (int i = 14; i >= 1; --i) p = 1.0 + p * r / (double)i;
    const long long e = (long long)k + 1023; const double sc = __longlong_as_double(e << 52);
    return p * sc;
}
__device__ __forceinline__ void dsincos_(double x, double& s, double& c) {
    const double k = __builtin_rint(x * 0.63661977236758134308); double r = __builtin_fma(-k, 1.57079632679489655800e+00, x); r = __builtin_fma(-k, 6.12323399573676603587e-17, r);
    const double r2 = r * r;
    double ps = 1.0, pc = 1.0;
#pragma unroll
    for (int i = 8; i >= 1; --i) { ps = 1.0 - ps * r2 / (double)((2 * i) * (2 * i + 1)); pc = 1.0 - pc * r2 / (double)((2 * i - 1) * (2 * i)); }
    ps *= r;
    const int q = ((int)((long long)k & 3ll) + 4) & 3;
    s = (q == 0) ? ps : (q == 1) ? pc : (q == 2) ? -ps : -pc;
    c = (q == 0) ? pc : (q == 1) ? -ps : (q == 2) ? -pc : ps;
}

__global__ void __launch_bounds__(512, 2) mega_fwd(Args args) {
    extern __shared__ __attribute__((aligned(16))) unsigned char lds_raw[];
    LAS unsigned char* lds = (LAS unsigned char*)lds_raw;
    cg::grid_group grid = cg::this_grid();
    const int tid0 = threadIdx.x, wave = __builtin_amdgcn_readfirstlane(tid0 >> 6);
    const int G = gridDim.x, bx = blockIdx.x;
    const int gw = bx * 8 + wave, NGW = G * 8;
    unsigned char* ws = args.ws; float* dout = args.out;
#define WIN_T ((bf16*)(ws + WS_WIN))
#define WKV_T ((bf16*)(ws + WS_WKV))
#define POOLW_T ((bf16*)(ws + WS_POOLW))
#define GLUW_T ((bf16*)(ws + WS_GLUW))
#define BCAT ((bf16*)(ws + WS_PPROJ))
#define WOUT_T ((bf16*)(ws + WS_WOUT))
#define W1_T ((bf16*)(ws + WS_W1))
#define W2_T ((bf16*)(ws + WS_W2))
#define XN ((bf16*)(ws + WS_XN))
#define MN ((bf16*)(ws + WS_MN))
#define UPOOL ((float*)(ws + WS_UPOOL))
#define USSM ((float*)(ws + WS_USSM))
#define X1 ((float*)(ws + WS_X1))
#define QB ((bf16*)(ws + WS_Q))
#define GATES ((bf16*)(ws + WS_GATES))
#define KB ((bf16*)(ws + WS_KB))
#define VT ((bf16*)(ws + WS_VT))
#define POOLED ((bf16*)(ws + WS_POOLED))
#define ZG ((bf16*)(ws + WS_ZG))
#define PB ((bf16*)(ws + WS_P))
#define ACAT ((bf16*)(ws + WS_ACAT))
#define MERGEDB ((bf16*)(ws + WS_MERGEDB))
#define HB ((bf16*)(ws + WS_H))
#define X2 ((float*)(ws + WS_X2))
#define PAB ((float*)(ws + WS_PAR + PAR_AB))
#define PBB ((float*)(ws + WS_PAR + PAR_BB))
#define PCMT ((bf16*)(ws + WS_PAR + PAR_CMT))
#define RSS ((float*)(ws + WS_PAR + PAR_RSS))
    {
        const int tid = opq(tid0), lane = tid & 63; (void)tid; (void)lane;
        LAS float* scr = (LAS float*)(lds + wave * 16640);
        constexpr int I_IN = 32 * 144, I_KV = 32 * 16, I_PW = 4 * 4, I_GL = 16 * 16, I_PJ = 16 * 32, I_OUT = 32 * 32, I_1 = 32 * 128, I_2 = 128 * 32;
        constexpr int NITEMS = I_IN + 2 * I_KV + 4 * I_PW + I_GL + 3 * I_PJ + I_OUT + I_1 + I_2;
        for (int it = gw; it < NITEMS; it += NGW) {
            int r = it;
            if (r < I_IN) { transpose_item(args.in[I_WIN], 2048, 9216, WIN_T, scr, r, lane); continue; } r -= I_IN;
            if (r < I_KV) { transpose_item(args.in[I_WK], 2048, 1024, WKV_T, scr, r, lane); continue; } r -= I_KV;
            if (r < I_KV) { transpose_item(args.in[I_WV], 2048, 1024, WKV_T + (size_t)1024 * 2048, scr, r, lane); continue; } r -= I_KV;
            if (r < 4 * I_PW) { const int g = r / I_PW; transpose_item(args.in[I_POOLW] + (size_t)g * 65536, 256, 256, POOLW_T + (size_t)g * 256, scr, r % I_PW, lane, 1024); continue; } r -= 4 * I_PW;
            if (r < I_GL) { transpose_item(args.in[I_GLUW], 1024, 1024, GLUW_T, scr, r, lane); continue; } r -= I_GL;
            if (r < I_PJ) { transpose_item(args.in[I_PPROJ], 1024, 2048, BCAT, scr, r, lane, 3072); continue; } r -= I_PJ;
            if (r < I_PJ) { transpose_item(args.in[I_SPROJ], 1024, 2048, BCAT + 1024, scr, r, lane, 3072); continue; } r -= I_PJ;
            if (r < I_PJ) { transpose_item(args.in[I_WO], 1024, 2048, BCAT + 2048, scr, r, lane, 3072); continue; } r -= I_PJ;
            if (r < I_OUT) { transpose_item(args.in[I_WOUT], 2048, 2048, WOUT_T, scr, r, lane); continue; } r -= I_OUT;
            if (r < I_1) { transpose_item(args.in[I_W1], 2048, 8192, W1_T, scr, r, lane); continue; } r -= I_1;
            transpose_item(args.in[I_W2], 8192, 2048, W2_T, scr, r, lane, LDH);
        }
        for (int m = gw; m < MT; m += NGW) { const float* xr = (m < MP) ? args.in[I_XP] + (size_t)m * DM : args.in[I_XS] + (size_t)(m - MP) * DM; rms_row<true>(xr, args.in[I_N1G], XN + (size_t)m * DM, lane); }
        for (int m = gw; m < 1024; m += NGW) rms_row<true>(args.in[I_MEM] + (size_t)m * DM, args.in[I_MNG], MN + (size_t)m * DM, lane);
        for (int i = bx * 512 + tid; i < MT; i += G * 512) RSS[i] = 0.f;
        if (bx == 0) { ((unsigned*)ws)[tid] = 0u; }
        for (int i = bx * 512 + tid; i < 4096; i += G * 512) {
            const int g = i >> 6, n = i & 63;
            const double dt = dexp_((double)args.in[I_LOGDT][g]); const double ar = (double)args.in[I_ARE][i], ai = (double)args.in[I_AIM][i];
            const double mag = dexp_(dt * ar); double sn, cs; dsincos_(dt * ai, sn, cs);
            const double abr = mag * cs, abi = mag * sn, den = ar * ar + ai * ai, xr = abr - 1.0, xi = abi;
            const double fr = (xr * ar + xi * ai) / den, fi = (xi * ar - xr * ai) / den;
            PAB[i * 2 + 0] = (float)abr; PAB[i * 2 + 1] = (float)abi;
            for (int p = 0; p < 16; ++p) { const double br = (double)args.in[I_BRE][i * 16 + p], bi = (double)args.in[I_BIM][i * 16 + p];
                PBB[i * 32 + p] = (float)(fr * br - fi * bi); PBB[i * 32 + 16 + p] = (float)(fr * bi + fi * br); }
            for (int p = 0; p < 16; ++p) { PCMT[(size_t)g * 2048 + p * 128 + n] = f2bf(args.in[I_CRE][(g * 16 + p) * 64 + n]); PCMT[(size_t)g * 2048 + p * 128 + 64 + n] = f2bf(-args.in[I_CIM][(g * 16 + p) * 64 + n]); }
        }
    }
    grid.sync();

    {
        pg8::StreamK<3, 5> S; S.nt = 32; S.seq = 1; S.ackseq = 0; S.split = SPLIT_P1; S.flags = (unsigned*)(ws + WS_FLAGS); S.acks = (unsigned*)(ws + WS_ACKS); S.slab = ws + WS_SLAB; S.init(G, bx, 1296 + 32);
        S.s[0] = pg8::Sub{(const char*)XN, (const char*)WIN_T, 36, 36, 1, 0, 256ll * 2048 * 2, 0, 0, 256ll * 2048 * 2};
        S.s[1] = pg8::Sub{(const char*)MN, (const char*)WKV_T, 4, 4, 1, 0, 256ll * 2048 * 2, 0, 0, 256ll * 2048 * 2};
        S.s[2] = pg8::Sub{(const char*)(WKV_T + (size_t)1024 * 2048), (const char*)MN, 4, 4, 1, 0, 256ll * 2048 * 2, 0, 0, 256ll * 2048 * 2};
        EpiIn E{UPOOL, USSM, QB, GATES, args.in[I_BGATE], dout + O_MK, KB, dout + O_MV, VT};
        pg8::gemm_phase<EpiIn, pg8::StreamK<3, 5>, true, true>(lds, pg8::Gemm{2048, 2048, 2048}, S, E);
    }
    grid.sync();

    {
        pg8::MultiOrder<1> S; S.G = G; S.c = bx; S.nt = 4;
        S.s[0] = pg8::Sub{(const char*)QB, (const char*)KB, 32, 4, 8, 0, 256ll * 1024 * 2, 256ll * 2, 256ll * 1024 * 2, 256ll * 2};
        EpiSoftmax E{PB};
        pg8::gemm_phase<EpiSoftmax, pg8::MultiOrder<1>, false, true>(lds, pg8::Gemm{256, 1024, 1024}, S, E);
    }
    __syncthreads();
    {
        const int tid = opq(tid0), lane = tid & 63; (void)tid; (void)lane;
        LAS float* Ub = (LAS float*)(lds + wave * 2048);
        LAS bf16* Hs = (LAS bf16*)(lds + 16384 + wave * 8704);
        LAS f32x2* Xc = (LAS f32x2*)(lds + 16384 + 8 * 8704);
        for (int job = bx; job < 256; job += G) {
            const int b = job >> 6, g = job & 63;
            const float abr = PAB[(g * 64 + lane) * 2], abi = PAB[(g * 64 + lane) * 2 + 1];
            float bbr[16], bbi[16];
#pragma unroll
            for (int p4 = 0; p4 < 4; ++p4) { const f32x4 x = *(const f32x4*)(PBB + (size_t)(g * 64 + lane) * 32 + 4 * p4), y = *(const f32x4*)(PBB + (size_t)(g * 64 + lane) * 32 + 16 + 4 * p4);
#pragma unroll
                for (int e = 0; e < 4; ++e) { bbr[4 * p4 + e] = x[e]; bbi[4 * p4 + e] = y[e]; } }
            bf16x8 cf[4];
#pragma unroll
            for (int ks = 0; ks < 4; ++ks) cf[ks] = *(const bf16x8*)(PCMT + (size_t)g * 2048 + (lane & 15) * 128 + ks * 32 + 8 * (lane >> 4));
            const float dsk = args.in[I_DSK][g * 16 + (lane & 15)];
            float pr = abr, pi = abi;
#pragma unroll
            for (int i = 0; i < 5; ++i) { const float nr = pr * pr - pi * pi, ni = 2.f * pr * pi; pr = nr; pi = ni; }
            float cr = 0.f, ci = 0.f;
            for (int blk = 0; blk < 8; ++blk) {
                const int row0 = b * 2048 + blk * 256 + wave * 32;
                { const int tok = lane >> 1, hf = lane & 1; const float* src = USSM + (size_t)(row0 + tok) * 1024 + g * 16 + hf * 8;
                  const f32x4 a0 = *(const f32x4*)src, a1 = *(const f32x4*)(src + 4); *(LAS f32x4*)(Ub + tok * 16 + hf * 8) = a0; *(LAS f32x4*)(Ub + tok * 16 + hf * 8 + 4) = a1; }
                asm volatile("s_waitcnt lgkmcnt(0)" ::: "memory");
                float hr = 0.f, hi = 0.f;
#pragma unroll 2
                for (int t = 0; t < 32; ++t) {
                    float bur = 0.f, bui = 0.f;
#pragma unroll
                    for (int p4 = 0; p4 < 4; ++p4) { const f32x4 uu = *(const LAS f32x4*)(Ub + t * 16 + 4 * p4);
#pragma unroll
                        for (int e = 0; e < 4; ++e) { bur += bbr[4 * p4 + e] * uu[e]; bui += bbi[4 * p4 + e] * uu[e]; } }
                    const float nr = abr * hr - abi * hi + bur, ni = abr * hi + abi * hr + bui; hr = nr; hi = ni;
                    Hs[t * 136 + lane] = f2bf(hr); Hs[t * 136 + 64 + lane] = f2bf(hi);
                }
                Xc[wave * 64 + lane] = (f32x2){hr, hi};
                __syncthreads();
                float hinr = 0.f, hini = 0.f, rr = cr, ri = ci;
#pragma unroll
                for (int w2 = 0; w2 < 8; ++w2) { if (w2 == wave) { hinr = rr; hini = ri; } const f32x2 e = Xc[w2 * 64 + lane]; const float nr = pr * rr - pi * ri + e.x, ni = pr * ri + pi * rr + e.y; rr = nr; ri = ni; }
                cr = rr; ci = ri;
                if (blk == 7 && wave == 7) { dout[O_REP + (size_t)(b * 64 + g) * 64 + lane] = rr; dout[O_IMP + (size_t)(b * 64 + g) * 64 + lane] = ri; }
                float qr = abr, qi = abi;
#pragma unroll 2
                for (int t = 0; t < 32; ++t) {
                    const float tr = bf2f(Hs[t * 136 + lane]) + qr * hinr - qi * hini, ti = bf2f(Hs[t * 136 + 64 + lane]) + qr * hini + qi * hinr;
                    Hs[t * 136 + lane] = f2bf(tr); Hs[t * 136 + 64 + lane] = f2bf(ti);
                    const float nq = qr * abr - qi * abi, nqi = qr * abi + qi * abr; qr = nq; qi = nqi;
                }
                asm volatile("s_waitcnt lgkmcnt(0)" ::: "memory");
#pragma unroll
                for (int rb = 0; rb < 2; ++rb) {
                    f32x4 acc = {0.f, 0.f, 0.f, 0.f};
#pragma unroll
                    for (int ks = 0; ks < 4; ++ks) { const bf16x8 af = *(const LAS bf16x8*)(Hs + (rb * 16 + (lane & 15)) * 136 + ks * 32 + 8 * (lane >> 4)); acc = __builtin_amdgcn_mfma_f32_16x16x32_bf16(af, cf[ks], acc, 0, 0, 0); }
#pragma unroll
                    for (int r = 0; r < 4; ++r) { const int t = rb * 16 + 4 * (lane >> 4) + r, p = lane & 15; const float y = acc[r] + dsk * Ub[t * 16 + p];
                        ZG[(size_t)(row0 + t) * 1024 + g * 16 + p] = f2bf(gelu_tanh(y)); }
                }
                __syncthreads();
            }
        }
        for (int job = gw; job < 8192; job += NGW) {
            const int b = job >> 6, g = job & 63;
            const float abr = PAB[(g * 64 + lane) * 2], abi = PAB[(g * 64 + lane) * 2 + 1];
            float bbr[16], bbi[16];
#pragma unroll
            for (int p4 = 0; p4 < 4; ++p4) { const f32x4 x = *(const f32x4*)(PBB + (size_t)(g * 64 + lane) * 32 + 4 * p4), y = *(const f32x4*)(PBB + (size_t)(g * 64 + lane) * 32 + 16 + 4 * p4);
#pragma unroll
                for (int e = 0; e < 4; ++e) { bbr[4 * p4 + e] = x[e]; bbi[4 * p4 + e] = y[e]; } }
            bf16x8 cf[4];
#pragma unroll
            for (int ks = 0; ks < 4; ++ks) cf[ks] = *(const bf16x8*)(PCMT + (size_t)g * 2048 + (lane & 15) * 128 + ks * 32 + 8 * (lane >> 4));
            const float dsk = args.in[I_DSK][g * 16 + (lane & 15)];
            const int row0 = MP + b * 8;
            if (lane < 16) { const int tok = lane >> 1, hf = lane & 1; const float* src = USSM + (size_t)(row0 + tok) * 1024 + g * 16 + hf * 8;
                const f32x4 a0 = *(const f32x4*)src, a1 = *(const f32x4*)(src + 4); *(LAS f32x4*)(Ub + tok * 16 + hf * 8) = a0; *(LAS f32x4*)(Ub + tok * 16 + hf * 8 + 4) = a1; }
            float hr = args.in[I_SRE][(size_t)(b * 64 + g) * 64 + lane], hi = args.in[I_SIM][(size_t)(b * 64 + g) * 64 + lane];
            asm volatile("s_waitcnt lgkmcnt(0)" ::: "memory");
#pragma unroll
            for (int t = 0; t < 8; ++t) {
                float bur = 0.f, bui = 0.f;
#pragma unroll
                for (int p4 = 0; p4 < 4; ++p4) { const f32x4 uu = *(const LAS f32x4*)(Ub + t * 16 + 4 * p4);
#pragma unroll
                    for (int e = 0; e < 4; ++e) { bur += bbr[4 * p4 + e] * uu[e]; bui += bbi[4 * p4 + e] * uu[e]; } }
                const float nr = abr * hr - abi * hi + bur, ni = abr * hi + abi * hr + bui; hr = nr; hi = ni;
                Hs[t * 136 + lane] = f2bf(hr); Hs[t * 136 + 64 + lane] = f2bf(hi);
            }
            dout[O_RES + (size_t)(b * 64 + g) * 64 + lane] = hr; dout[O_IMS + (size_t)(b * 64 + g) * 64 + lane] = hi;
            asm volatile("s_waitcnt lgkmcnt(0)" ::: "memory");
            f32x4 acc = {0.f, 0.f, 0.f, 0.f};
#pragma unroll
            for (int ks = 0; ks < 4; ++ks) { const bf16x8 af = *(const LAS bf16x8*)(Hs + (lane & 15) * 136 + ks * 32 + 8 * (lane >> 4)); acc = __builtin_amdgcn_mfma_f32_16x16x32_bf16(af, cf[ks], acc, 0, 0, 0); }
            if (lane < 32) {
#pragma unroll
                for (int r = 0; r < 4; ++r) { const int t = 4 * (lane >> 4) + r, p = lane & 15; const float y = acc[r] + dsk * Ub[t * 16 + p];
                    ZG[(size_t)(row0 + t) * 1024 + g * 16 + p] = f2bf(gelu_tanh(y)); }
            }
            asm volatile("s_waitcnt lgkmcnt(0)" ::: "memory");
        }
    }
    __syncthreads();
    {
        const int tid = opq(tid0), lane = tid & 63; (void)tid; (void)lane;
        const float* spool = args.in[I_SPOOL];
        for (int it = bx * 512 + tid; it < MT * 256; it += G * 512) {
            const int m = it >> 8, c4 = it & 255, k = c4 >> 6, w = 2 << k;
            f32x4 s = {0.f, 0.f, 0.f, 0.f}; float cnt;
            if (m < MP) { const int t = m & 2047, nv = (t + 1 < w) ? t + 1 : w; cnt = (float)nv;
                for (int j = 0; j < nv; ++j) s = s + *(const f32x4*)(UPOOL + (size_t)(m - j) * 1024 + 4 * c4);
            } else { const int bs = (m - MP) >> 3, t = (m - MP) & 7; cnt = (float)w;
                for (int j = 0; j < w; ++j) { const int e = 15 + t - j; const float* src = (e >= 15) ? UPOOL + (size_t)(MP + bs * 8 + (e - 15)) * 1024 : spool + (size_t)(bs * 15 + e) * 1024; s = s + *(const f32x4*)(src + 4 * c4); }
            }
            const f32x4 cur = *(const f32x4*)(UPOOL + (size_t)m * 1024 + 4 * c4);
            st_bf4(POOLED + (size_t)m * 1024 + 4 * c4, s / cnt - cur);
        }
        for (int it = bx * 512 + tid; it < 4 * 15 * 256; it += G * 512) { const int c4 = it & 255, i = (it >> 8) % 15, b = it / (15 * 256);
            *(f32x4*)(dout + O_POOLP + (size_t)(b * 15 + i) * 1024 + 4 * c4) = *(const f32x4*)(UPOOL + (size_t)(b * 2048 + 2033 + i) * 1024 + 4 * c4); }
        for (int it = bx * 512 + tid; it < 128 * 15 * 256; it += G * 512) { const int c4 = it & 255, i = (it >> 8) % 15, b = it / (15 * 256); const int e = 8 + i;
            const float* src = (e >= 15) ? UPOOL + (size_t)(MP + b * 8 + (e - 15)) * 1024 : spool + (size_t)(b * 15 + e) * 1024;
            *(f32x4*)(dout + O_POOLS + (size_t)(b * 15 + i) * 1024 + 4 * c4) = *(const f32x4*)(src + 4 * c4); }
    }
    {
        const int tid = opq(tid0), lane = tid & 63; (void)tid; (void)lane;
        LAS float* qs = (LAS float*)lds; LAS float* Ss = (LAS float*)(lds + 8192); LAS float* Pm = (LAS float*)(lds + 16384);
        const float* ck = args.in[I_CK]; const float* cv = args.in[I_CV];
        for (int unit = bx; unit < 512; unit += G) {
            const int b = unit >> 2, h = unit & 3;
            { const int idx = tid * 4, i = idx >> 8, d = idx & 255; const f32x4 qv = ld_bf4(QB + (size_t)(MP + b * 8 + i) * 1024 + h * 256 + d); *(LAS f32x4*)(qs + idx) = qv; }
            __syncthreads();
            {
                const int rot = (b * 2 + wave * 32) & 255;
                const int l15 = lane & 15, l4 = lane >> 4;
                const float* kp = ck + ((size_t)(b * 256) * 4 + h) * 256 + 8 * l4;
                f32x4 kr[2][8][2];
#pragma unroll
                for (int blk = 0; blk < 2; ++blk) { const float* rp = kp + (size_t)((rot + blk * 16 + l15) & 255) * 1024;
#pragma unroll
                    for (int ks = 0; ks < 8; ++ks) { kr[blk][ks][0] = *(const f32x4*)(rp + ks * 32); kr[blk][ks][1] = *(const f32x4*)(rp + ks * 32 + 4); } }
                bf16x8 qf[8];
#pragma unroll
                for (int ks = 0; ks < 8; ++ks) { f32x4 a = {0.f, 0.f, 0.f, 0.f}, b2 = {0.f, 0.f, 0.f, 0.f};
                    if (l15 < 8) { a = *(const LAS f32x4*)(qs + l15 * 256 + ks * 32 + 8 * l4); b2 = *(const LAS f32x4*)(qs + l15 * 256 + ks * 32 + 8 * l4 + 4); }
                    u32x4 w; w.x = cvt_pk_bf16(a[0], a[1]); w.y = cvt_pk_bf16(a[2], a[3]); w.z = cvt_pk_bf16(b2[0], b2[1]); w.w = cvt_pk_bf16(b2[2], b2[3]); qf[ks] = __builtin_bit_cast(bf16x8, w); }
#pragma unroll
                for (int blk = 0; blk < 2; ++blk) {
                    f32x4 acc = {0.f, 0.f, 0.f, 0.f};
#pragma unroll
                    for (int ks = 0; ks < 8; ++ks) { const f32x4 a = kr[blk][ks][0], b2 = kr[blk][ks][1];
                        u32x4 w; w.x = cvt_pk_bf16(a[0], a[1]); w.y = cvt_pk_bf16(a[2], a[3]); w.z = cvt_pk_bf16(b2[0], b2[1]); w.w = cvt_pk_bf16(b2[2], b2[3]);
                        acc = __builtin_amdgcn_mfma_f32_16x16x32_bf16(__builtin_bit_cast(bf16x8, w), qf[ks], acc, 0, 0, 0); }
                    if (l15 < 8) {
#pragma unroll
                        for (int r = 0; r < 4; ++r) Ss[l15 * 256 + ((rot + blk * 16 + 4 * l4 + r) & 255)] = acc[r] * 0.0625f; }
                }
            }
            __syncthreads();
            { const f32x4 s4 = *(const LAS f32x4*)(Ss + wave * 256 + 4 * lane); const float mx = wave_max(fmaxf(fmaxf(s4[0], s4[1]), fmaxf(s4[2], s4[3])));
              f32x4 e; e[0] = __expf(s4[0] - mx); e[1] = __expf(s4[1] - mx); e[2] = __expf(s4[2] - mx); e[3] = __expf(s4[3] - mx);
              const float inv = 1.0f / wave_sum((e[0] + e[1]) + (e[2] + e[3]));
#pragma unroll
              for (int j = 0; j < 4; ++j) Pm[(4 * lane + j) * 8 + wave] = e[j] * inv; }
            __syncthreads();
            {
                const int rot = (b * 2 + wave * 32) & 255;
                const float* vp = cv + ((size_t)(b * 256) * 4 + h) * 256 + 4 * lane;
                f32x4 o[8];
#pragma unroll
                for (int i = 0; i < 8; ++i) o[i] = (f32x4){0.f, 0.f, 0.f, 0.f};
                f32x4 vb[2][8];
#pragma unroll
                for (int r = 0; r < 8; ++r) vb[0][r] = *(const f32x4*)(vp + (size_t)((rot + r) & 255) * 1024);
#pragma unroll
                for (int bt = 0; bt < 4; ++bt) {
                    if (bt < 3) {
#pragma unroll
                        for (int r = 0; r < 8; ++r) vb[(bt + 1) & 1][r] = *(const f32x4*)(vp + (size_t)((rot + (bt + 1) * 8 + r) & 255) * 1024);
                    }
#pragma unroll
                    for (int r = 0; r < 8; ++r) { const int mem = (rot + bt * 8 + r) & 255; const f32x4 v = vb[bt & 1][r];
                        const f32x4 p0 = *(const LAS f32x4*)(Pm + mem * 8), p1 = *(const LAS f32x4*)(Pm + mem * 8 + 4);
#pragma unroll
                        for (int i = 0; i < 4; ++i) { o[i] = o[i] + v * p0[i]; o[4 + i] = o[4 + i] + v * p1[i]; } }
                }
                LAS float* Op = (LAS float*)(lds + 32768);
#pragma unroll
                for (int i = 0; i < 8; ++i) *(LAS f32x4*)(Op + (wave * 8 + i) * 256 + 4 * lane) = o[i];
                __syncthreads();
                { const int idx = tid * 4, i = idx >> 8, d = idx & 255; f32x4 s = {0.f, 0.f, 0.f, 0.f};
#pragma unroll
                  for (int w2 = 0; w2 < 8; ++w2) s = s + *(const LAS f32x4*)(Op + (w2 * 8 + i) * 256 + d);
                  st_bf4(ACAT + (size_t)(MP + b * 8 + i) * 3072 + 2048 + h * 256 + d, s); }
            }
            __syncthreads();
        }
    }
    grid.sync();

    {
        pg8::MultiOrder<3> S; S.G = G; S.c = bx; S.nt = 16;
        S.s[0] = pg8::Sub{(const char*)ZG, (const char*)GLUW_T, 36, 4, 1, 16, 256ll * 1024 * 2, 0, 0, 256ll * 1024 * 2};
        S.s[1] = pg8::Sub{(const char*)POOLED, (const char*)POOLW_T, 36, 4, 1, 4, 256ll * 1024 * 2, 256ll * 2, 0, 256ll * 2};
        S.s[2] = pg8::Sub{(const char*)PB, (const char*)VT, 32, 4, 8, 4, 256ll * 1024 * 2, 256ll * 2, 256ll * 1024 * 2, 256ll * 2};
        EpiP3 E{ACAT, args.in[I_GLUB], ZG, args.in[I_PSCALE]};
        pg8::gemm_phase<EpiP3, pg8::MultiOrder<3>, true, true>(lds, pg8::Gemm{1024, 1024, 1024}, S, E);
    }
    grid.sync();

    {
        pg8::MultiOrder<1> S; S.G = G; S.c = bx; S.nt = 48;
        S.s[0] = pg8::Sub{(const char*)ACAT, (const char*)BCAT, 36, 8, 1, 0, 256ll * 3072 * 2, 0, 0, 256ll * 3072 * 2};
        EpiMergeK E{GATES, MERGEDB};
        pg8::gemm_phase<EpiMergeK, pg8::MultiOrder<1>, true, true>(lds, pg8::Gemm{3072, 3072, 3072}, S, E);
    }
    grid.sync();

    {
        pg8::StreamK<1, 7> S; S.nt = 32; S.seq = 5; S.ackseq = 0; S.split = SPLIT_P5; S.flags = (unsigned*)(ws + WS_FLAGS); S.acks = (unsigned*)(ws + WS_ACKS); S.slab = ws + WS_SLAB; S.init(G, bx, 288);
        S.s[0] = pg8::Sub{(const char*)MERGEDB, (const char*)WOUT_T, 36, 8, 1, 0, 256ll * 2048 * 2, 0, 0, 256ll * 2048 * 2};
        EpiResidN E{args.in[I_XP], args.in[I_XS], MP, X1, XN, args.in[I_N2G], RSS};
        pg8::gemm_phase<EpiResidN, pg8::StreamK<1, 7>, true, true>(lds, pg8::Gemm{2048, 2048, 2048}, S, E);
    }
    grid.sync();

    {
        pg8::StreamK<1, 1> S; S.nt = 32; S.seq = 6; S.ackseq = 0; S.split = SPLIT_P6; S.flags = (unsigned*)(ws + WS_FLAGS); S.acks = (unsigned*)(ws + WS_ACKS); S.slab = ws + WS_SLAB; S.init(G, bx, 1152);
        S.s[0] = pg8::Sub{(const char*)XN, (const char*)W1_T, 36, 32, 1, 0, 256ll * 2048 * 2, 0, 0, 256ll * 2048 * 2};
        EpiH E{HB, LDH, RSS};
        pg8::gemm_phase<EpiH, pg8::StreamK<1, 1>, true, true>(lds, pg8::Gemm{2048, 2048, 2048}, S, E);
    }
    grid.sync();

    {
        pg8::StreamK<1, 7> S; S.nt = 128; S.seq = 7; S.ackseq = 0; S.split = SPLIT_P7; S.flags = (unsigned*)(ws + WS_FLAGS); S.acks = (unsigned*)(ws + WS_ACKS); S.slab = ws + WS_SLAB; S.init(G, bx, 288);
        S.s[0] = pg8::Sub{(const char*)HB, (const char*)W2_T, 36, 8, 1, 0, 256ll * LDH * 2, 0, 0, 256ll * LDH * 2};
        EpiResid E{X1, X1, MT, X2};
        pg8::gemm_phase<EpiResid, pg8::StreamK<1, 7>, true, true>(lds, pg8::Gemm{8192, LDH, LDH}, S, E);
    }
    grid.sync();

    { const int tid = opq(tid0), lane = tid & 63; (void)tid; (void)lane;
      for (int m = gw; m < MT; m += NGW) rms_row<false>(X2 + (size_t)m * DM, args.in[I_FNG], dout + (size_t)m * DM, lane); }
}

extern "C" void kernel_launch(void* const* d_in, const int* in_sizes, int n_in, void* d_out, int out_size, void* d_ws, size_t ws_size, hipStream_t stream) {
    static int grid = 0;
    if (grid == 0) {
        if (n_in != N_IN || ws_size < WS_END) { fprintf(stderr, "kernel_launch: expected %d inputs and >= %zu bytes of workspace; got %d, %zu; nothing launched\n", (int)N_IN, (size_t)WS_END, n_in, ws_size); grid = -1; return; }
        int dev = 0, cus = 0, per_cu = 0;
        if (hipGetDevice(&dev) != hipSuccess || hipDeviceGetAttribute(&cus, hipDeviceAttributeMultiprocessorCount, dev) != hipSuccess) { fprintf(stderr, "kernel_launch: device query failed\n"); grid = -1; return; }
        if (hipFuncSetAttribute((const void*)mega_fwd, hipFuncAttributeMaxDynamicSharedMemorySize, LDS_BYTES) != hipSuccess) { fprintf(stderr, "kernel_launch: hipFuncSetAttribute failed\n"); grid = -1; return; }
        if (hipOccupancyMaxActiveBlocksPerMultiprocessor(&per_cu, (const void*)mega_fwd, 512, LDS_BYTES) != hipSuccess || per_cu < 1) { fprintf(stderr, "kernel_launch: occupancy query says %d blocks per CU\n", per_cu); per_cu = 1; }
        (void)hipGetLastError();
        grid = cus;
        if (grid > 256) grid = 256;
        if (grid != 256) fprintf(stderr, "kernel_launch: %d workgroups; the stream-K chunking assumes 256 (chunk >= one unit)\n", grid);
        if (grid < 144) fprintf(stderr, "kernel_launch: only %d CUs; the one-unit-per-workgroup attention phase needs >= 144\n", grid);
    }
    if (grid < 0) return;
    Args a{};
    for (int i = 0; i < N_IN; ++i) a.in[i] = (const float*)d_in[i];
    a.out = (float*)d_out; a.ws = (unsigned char*)d_ws;
    void* kargs[] = {&a};
    hipError_t e = hipLaunchCooperativeKernel((const void*)mega_fwd, dim3(grid), dim3(512), kargs, LDS_BYTES, stream);
    if (e != hipSuccess) fprintf(stderr, "kernel_launch: cooperative launch failed: %s (grid %d)\n", hipGetErrorString(e), grid);
}
```
